# Optimizing an MI355X kernel written in HIP

```python
import math
import jax, jax.numpy as jnp
from jax import lax
import numpy as np

D_MODEL = 1024
BATCH = 16
SEQ = 2048
DEPTH = 2

N_MIXERS = 2
N_HEADS = 16
HEAD_DIM = D_MODEL // N_HEADS
NSA_KV_GROUPS = 4
NSA_HPG = N_HEADS // NSA_KV_GROUPS
CMP_BLOCK = 32
CMP_STRIDE = 16
SEL_BLOCK = 64
SEL_TOPK = 16
N_LOCAL_BLOCKS = 2
WINDOW = 512
SEL_Q_CHUNK = 16
Q_BLOCK = 128
NSA_IN = N_HEADS * HEAD_DIM + 6 * NSA_KV_GROUPS * HEAD_DIM + 3 * N_HEADS
FOX_IN = 3 * N_HEADS * HEAD_DIM + N_HEADS
REL_BUCKETS = 32
REL_MAX_DIST = 128
D_FF = 4 * D_MODEL
RMS_EPS = 1e-6
N_NSA_LAYERS = (DEPTH + 1) // 2
N_FOX_LAYERS = DEPTH // 2
NEG_INF = -1e30
FORCE_SCORE = 1e9

kernel_name = "nsa_fox_interleaved_hybrid"


def rms_norm(x, g):
    xf = x.astype(jnp.float32)
    y = xf * lax.rsqrt(jnp.mean(xf * xf, axis=-1, keepdims=True) + RMS_EPS)
    return (y * g.astype(jnp.float32)).astype(x.dtype)


def rel_bucket(dist):
    n = jnp.maximum(dist, 0)
    max_exact = REL_BUCKETS // 2
    nf = jnp.maximum(n, 1).astype(jnp.float32)
    large = max_exact + (jnp.log(nf / max_exact) / math.log(REL_MAX_DIST / max_exact)
                         * (REL_BUCKETS - max_exact)).astype(jnp.int32)
    large = jnp.minimum(large, REL_BUCKETS - 1)
    return jnp.where(n < max_exact, n, large)


def masked_softmax(logits, mask):
    logits = jnp.where(mask, logits.astype(jnp.float32), NEG_INF)
    m = jnp.max(logits, axis=-1, keepdims=True)
    p = jnp.exp(logits - m) * mask
    return p / jnp.maximum(jnp.sum(p, axis=-1, keepdims=True), 1e-30)


def nsa_mixer(h, w_in, pe_k, wk1, wk2, pe_v, wv1, wv2, w_out, rel_bias):
    B, S, _ = h.shape
    H, G, Hg, Dh = N_HEADS, NSA_KV_GROUPS, NSA_HPG, HEAD_DIM
    proj = h @ w_in
    q = proj[..., :H * Dh].reshape(B, S, G, Hg, Dh).transpose(0, 2, 3, 1, 4) * (Dh ** -0.5)

    def kv(i):
        off = H * Dh + i * G * Dh
        return proj[..., off:off + G * Dh].reshape(B, S, G, Dh).transpose(0, 2, 1, 3)

    k_c, v_c, k_s, v_s, k_w, v_w = [kv(i) for i in range(6)]
    gates = jax.nn.sigmoid(proj[..., H * Dh + 6 * G * Dh:].astype(jnp.float32))
    gates = gates.reshape(B, S, 3, G, Hg).transpose(2, 0, 3, 4, 1)[..., None]
    t_pos = jnp.arange(S)
    g_ar = jnp.arange(G)
    rb_g = rel_bias.reshape(REL_BUCKETS, G, Hg).transpose(1, 0, 2)

    n_cmp = (S - CMP_BLOCK) // CMP_STRIDE + 1
    starts = jnp.arange(n_cmp) * CMP_STRIDE
    idx = starts[:, None] + jnp.arange(CMP_BLOCK)[None, :]

    def compress(t, pe, w1, w2):
        blocks = t[:, :, idx] + pe
        flat = blocks.reshape(B, G, n_cmp, CMP_BLOCK * Dh)
        return jax.nn.gelu(flat @ w1) @ w2

    kc = compress(k_c, pe_k, wk1, wk2)
    vc = compress(v_c, pe_v, wv1, wv2)
    dist_c = t_pos[:, None] - (starts + CMP_BLOCK - 1)[None, :]
    bias_c = rel_bias[rel_bucket(dist_c)].transpose(2, 0, 1).reshape(G, Hg, S, n_cmp)
    s_cmp = jnp.einsum('bghqd,bgcd->bghqc', q, kc).astype(jnp.float32) + bias_c
    p_cmp = masked_softmax(s_cmp, dist_c >= 0)
    o_cmp = jnp.einsum('bghqc,bgcd->bghqd', p_cmp.astype(vc.dtype), vc)

    n_sel = S // SEL_BLOCK
    n_topk = min(SEL_TOPK, n_sel)
    cells = jnp.arange(n_cmp)[:, None] + jnp.arange(CMP_BLOCK // CMP_STRIDE)[None, :]
    overlap = jnp.sum(jax.nn.one_hot(cells // (SEL_BLOCK // CMP_STRIDE), n_sel, dtype=jnp.float32), axis=1)
    imp = jnp.einsum('bghqc,cj->bgqj', p_cmp, overlap)
    j = jnp.arange(n_sel)
    rel_blk = (t_pos // SEL_BLOCK)[:, None] - j[None, :]
    forced = (j[None, :] == 0) | ((rel_blk >= 0) & (rel_blk < N_LOCAL_BLOCKS))
    visible = rel_blk >= 0
    score = jnp.where(visible, jnp.where(forced, FORCE_SCORE, imp), NEG_INF)
    _, sel_idx = lax.top_k(score, n_topk)

    kb = k_s.reshape(B, G, n_sel, SEL_BLOCK * Dh)
    vb = v_s.reshape(B, G, n_sel, SEL_BLOCK * Dh)
    n_chunk = S // SEL_Q_CHUNK
    q_ch = q.reshape(B, G, Hg, n_chunk, SEL_Q_CHUNK, Dh).transpose(3, 0, 1, 2, 4, 5)
    idx_ch = sel_idx.reshape(B, G, n_chunk, SEL_Q_CHUNK, n_topk).transpose(2, 0, 1, 3, 4)
    n_keys = n_topk * SEL_BLOCK

    def sel_chunk(args):
        qc, ic, c = args
        flat_idx = ic.reshape(B, G, SEL_Q_CHUNK * n_topk)[..., None]
        kg = jnp.take_along_axis(kb, flat_idx, axis=2).reshape(B, G, SEL_Q_CHUNK, n_keys, Dh)
        vg = jnp.take_along_axis(vb, flat_idx, axis=2).reshape(B, G, SEL_Q_CHUNK, n_keys, Dh)
        tq = c * SEL_Q_CHUNK + jnp.arange(SEL_Q_CHUNK)
        kpos = (ic[..., None] * SEL_BLOCK + jnp.arange(SEL_BLOCK)).reshape(B, G, SEL_Q_CHUNK, n_keys)
        dist = tq[None, None, :, None] - kpos
        bias = rb_g[g_ar[None, :, None, None], rel_bucket(dist)]
        s = jnp.einsum('bghqd,bgqkd->bghqk', qc, kg).astype(jnp.float32) + bias.transpose(0, 1, 4, 2, 3)
        p = masked_softmax(s, (dist >= 0)[:, :, None])
        return jnp.einsum('bghqk,bgqkd->bghqd', p.astype(vg.dtype), vg)

    o_sel = lax.map(sel_chunk, (q_ch, idx_ch, jnp.arange(n_chunk)))
    o_sel = o_sel.transpose(1, 2, 3, 0, 4, 5).reshape(B, G, Hg, S, Dh)

    n_qb = S // Q_BLOCK
    span = WINDOW + Q_BLOCK
    kp = jnp.pad(k_w, ((0, 0), (0, 0), (WINDOW, 0), (0, 0)))
    vp = jnp.pad(v_w, ((0, 0), (0, 0), (WINDOW, 0), (0, 0)))
    q_blk = q.reshape(B, G, Hg, n_qb, Q_BLOCK, Dh).transpose(3, 0, 1, 2, 4, 5)

    def win_block(args):
        qb_, i = args
        start = i * Q_BLOCK
        kblk = lax.dynamic_slice_in_dim(kp, start, span, axis=2)
        vblk = lax.dynamic_slice_in_dim(vp, start, span, axis=2)
        tq = start + jnp.arange(Q_BLOCK)
        kpos = start - WINDOW + jnp.arange(span)
        dist = tq[:, None] - kpos[None, :]
        mask = (dist >= 0) & (dist < WINDOW) & (kpos[None, :] >= 0)
        bias = rel_bias[rel_bucket(dist)].transpose(2, 0, 1).reshape(G, Hg, Q_BLOCK, span)
        s = jnp.einsum('bghqd,bgkd->bghqk', qb_, kblk).astype(jnp.float32) + bias
        p = masked_softmax(s, mask)
        return jnp.einsum('bghqk,bgkd->bghqd', p.astype(vblk.dtype), vblk)

    o_win = lax.map(win_block, (q_blk, jnp.arange(n_qb)))
    o_win = o_win.transpose(1, 2, 3, 0, 4, 5).reshape(B, G, Hg, S, Dh)

    o = (gates[0] * o_cmp + gates[1] * o_sel + gates[2] * o_win).astype(h.dtype)
    o = o.transpose(0, 3, 1, 2, 4).reshape(B, S, H * Dh)
    return o @ w_out


def fox_mixer(h, w_in, b_f, w_out):
    B, S, _ = h.shape
    H, Dh = N_HEADS, HEAD_DIM
    proj = h @ w_in

    def heads(i):
        return proj[..., i * H * Dh:(i + 1) * H * Dh].reshape(B, S, H, Dh).transpose(0, 2, 1, 3)

    q = heads(0) * (Dh ** -0.5)
    k = heads(1)
    v = heads(2)
    f_logit = proj[..., 3 * H * Dh:].astype(jnp.float32) + b_f.astype(jnp.float32)
    c = jnp.cumsum(jax.nn.log_sigmoid(f_logit), axis=1).transpose(0, 2, 1)
    n_qb = S // Q_BLOCK
    q_blk = q.reshape(B, H, n_qb, Q_BLOCK, Dh).transpose(2, 0, 1, 3, 4)
    c_blk = c.reshape(B, H, n_qb, Q_BLOCK).transpose(2, 0, 1, 3)
    kpos = jnp.arange(S)

    def blk(args):
        qb_, cq, i = args
        tq = i * Q_BLOCK + jnp.arange(Q_BLOCK)
        s = (jnp.einsum('bhqd,bhkd->bhqk', qb_, k).astype(jnp.float32)
             + cq[..., None] - c[:, :, None, :])
        p = masked_softmax(s, tq[:, None] >= kpos[None, :])
        return jnp.einsum('bhqk,bhkd->bhqd', p.astype(v.dtype), v)

    o = lax.map(blk, (q_blk, c_blk, jnp.arange(n_qb)))
    o = o.transpose(1, 0, 3, 2, 4).reshape(B, S, H * Dh)
    return o @ w_out


def sq_relu_mlp(h, w1, w2):
    a = jax.nn.relu(h @ w1)
    return (a * a) @ w2


def setup_inputs(seed: int = 0) -> dict:
    key = jax.random.key(seed)
    ks = jax.random.split(key, 24)
    f32 = jnp.float32
    Dh = HEAD_DIM

    def nrm(k, shape, scale):
        return jax.random.normal(k, shape, f32) * scale

    return {
        "x": nrm(ks[0], (BATCH, SEQ, D_MODEL), 1.0),
        "rel_bias": nrm(ks[1], (REL_BUCKETS, N_HEADS), 0.2),
        "norm_mix": 1.0 + nrm(ks[2], (DEPTH, D_MODEL), 0.05),
        "norm_mlp": 1.0 + nrm(ks[3], (DEPTH, D_MODEL), 0.05),
        "nsa_w_in": nrm(ks[4], (N_NSA_LAYERS, D_MODEL, NSA_IN), D_MODEL ** -0.5),
        "nsa_pe_k": nrm(ks[5], (N_NSA_LAYERS, CMP_BLOCK, Dh), 0.1),
        "nsa_wk1": nrm(ks[6], (N_NSA_LAYERS, CMP_BLOCK * Dh, Dh), (CMP_BLOCK * Dh) ** -0.5),
        "nsa_wk2": nrm(ks[7], (N_NSA_LAYERS, Dh, Dh), Dh ** -0.5),
        "nsa_pe_v": nrm(ks[8], (N_NSA_LAYERS, CMP_BLOCK, Dh), 0.1),
        "nsa_wv1": nrm(ks[9], (N_NSA_LAYERS, CMP_BLOCK * Dh, Dh), (CMP_BLOCK * Dh) ** -0.5),
        "nsa_wv2": nrm(ks[10], (N_NSA_LAYERS, Dh, Dh), Dh ** -0.5),
        "nsa_w_out": nrm(ks[11], (N_NSA_LAYERS, N_HEADS * Dh, D_MODEL), (N_HEADS * Dh) ** -0.5),
        "fox_w_in": nrm(ks[12], (N_FOX_LAYERS, D_MODEL, FOX_IN), D_MODEL ** -0.5),
        "fox_b_f": jax.random.uniform(ks[13], (N_FOX_LAYERS, N_HEADS), f32, 1.0, 4.0),
        "fox_w_out": nrm(ks[14], (N_FOX_LAYERS, N_HEADS * Dh, D_MODEL), (N_HEADS * Dh) ** -0.5),
        "mlp_w1": nrm(ks[15], (DEPTH, D_MODEL, D_FF), D_MODEL ** -0.5),
        "mlp_w2": nrm(ks[16], (DEPTH, D_FF, D_MODEL), D_FF ** -0.5),
        "final_norm": 1.0 + nrm(ks[17], (D_MODEL,), 0.05),
    }


def reference(x, rel_bias, norm_mix, norm_mlp, nsa_w_in, nsa_pe_k, nsa_wk1, nsa_wk2,
              nsa_pe_v, nsa_wv1, nsa_wv2, nsa_w_out, fox_w_in, fox_b_f, fox_w_out,
              mlp_w1, mlp_w2, final_norm):
    for i in range(DEPTH):
        hn = rms_norm(x, norm_mix[i])
        li = i // N_MIXERS
        if i % N_MIXERS == 0:
            mix = nsa_mixer(hn, nsa_w_in[li], nsa_pe_k[li], nsa_wk1[li], nsa_wk2[li],
                            nsa_pe_v[li], nsa_wv1[li], nsa_wv2[li], nsa_w_out[li], rel_bias)
        else:
            mix = fox_mixer(hn, fox_w_in[li], fox_b_f[li], fox_w_out[li])
        x = x + mix.astype(x.dtype)
        hn = rms_norm(x, norm_mlp[i])
        x = x + sq_relu_mlp(hn, mlp_w1[i], mlp_w2[i]).astype(x.dtype)
    return rms_norm(x, final_norm)
```

```cpp
#include <hip/hip_runtime.h>
#include <hip/hip_cooperative_groups.h>
#include <cstdint>
#include <cstdio>
namespace cg = cooperative_groups;

constexpr int D = 1024, NB = 16, S = 2048, NH = 16, DH = 64, G = 4, M = NB * S;
constexpr int NSA_IN = 2608, NSA_INP = 2816, FOX_IN = 3088, FOX_INP = 3328, DFF = 4096, NC = 127;
constexpr int KVW = 1536;
constexpr int FKVW = 2048;
constexpr float LOG2E = 1.4426950408889634f;
constexpr float C2 = 0.125f * LOG2E;
constexpr float RMS_EPS = 1e-6f;

namespace pg8 {
#define PG8_LAS __attribute__((address_space(3)))
typedef unsigned short bf16_t;
typedef short bf16x8 __attribute__((ext_vector_type(8)));
typedef float f32x4 __attribute__((ext_vector_type(4)));
typedef unsigned u32x4 __attribute__((ext_vector_type(4)));
typedef unsigned u32x2 __attribute__((ext_vector_type(2)));
constexpr int BM = 256, BK = 64, HALF = 128, HTB = HALF * BK * 2  , STAGE_BYTES = 8 * HTB, NXCD = 8, WGM = 8;

__host__ __device__ __forceinline__ int lds_byte(int r, int c) { const int st = (r >> 4) * 2 + (c >> 5), rr = r & 15, cc = c & 31, ob = rr * 64 + cc * 2; return st * 1024 + (ob ^ (((ob >> 9) & 1) << 5)); }
__host__ __device__ __forceinline__ void stage_rc(int b, int& R, int& C) { const int st = b / 1024, sb = b % 1024, swz = sb ^ (((sb >> 9) & 1) << 5); R = (st >> 1) * 16 + swz / 64; C = (st & 1) * 32 + (swz % 64) / 2; }
__host__ __device__ __forceinline__ int perm32(int rho) { const int n = rho >> 4, i = rho & 15; return 8 * (i >> 2) + 4 * n + (i & 3); }

struct Unit { int pm, pn; };
struct Gemm { const bf16_t* A; const bf16_t* Bt; int M, N, K; };

struct StaticOrder {
    int nM, nN, nwg, G, c;
    __host__ __device__ void init(int M, int N, int G_, int c_) { nM = M / BM; nN = N / BM; nwg = nM * nN; G = G_; c = c_; }
    __host__ __device__ bool next(int i, Unit& u) const {
        const long L = (long)i * G + c; if (L >= nwg) return false;
        int wgid = (int)L; { const int q = nwg / NXCD, r = nwg % NXCD, xcd = wgid % NXCD, off = wgid / NXCD; wgid = (xcd < r ? xcd * (q + 1) : r * (q + 1) + (xcd - r) * q) + off; }
        const int nig = WGM * nN, gid = wgid / nig, fm = gid * WGM, gsz = (nM - fm) < WGM ? (nM - fm) : WGM;
        u.pm = fm + ((wgid % nig) % gsz); u.pn = (wgid % nig) / gsz; return true;
    }
    __device__ __forceinline__ void a_ready(const Unit&) const {}
    __device__ __forceinline__ void done(const Unit&) const {}
};
__device__ __forceinline__ unsigned cvt_pk_bf16(float lo, float hi) { unsigned r; asm volatile("v_cvt_pk_bf16_f32 %0, %1, %2" : "=v"(r) : "v"(lo), "v"(hi)); return r; }
template <class Epi, class Sched, bool ALIGN_EPI = false, bool SP2 = false, bool AT = false>
__device__ __forceinline__ void gemm_phase(PG8_LAS unsigned char* lds, const Gemm g, const Sched& S, const Epi& E) {
    const int tid = threadIdx.x, wid = __builtin_amdgcn_readfirstlane(tid >> 6), lane = tid & 63, wr = wid >> 2, wc = wid & 3, fr = lane & 15, fq = lane >> 4;
    const int K = g.K, nt = K / BK;
    unsigned voffA[2], voffB[2];
#pragma unroll
    for (int i = 0; i < 2; ++i) { int R, C; stage_rc(tid * 16 + i * 8192, R, C); const int Rb = Epi::PERM ? ((R & ~31) + perm32(R & 31)) : R;
        voffA[i] = AT ? (unsigned)(R * 64 + C) * 2u : (unsigned)(R * K + C) * 2u; voffB[i] = (unsigned)(Rb * K + C) * 2u; }
    const size_t kstep = (size_t)(BK * 2);
    const size_t hstep = (size_t)HALF * K * 2;
    constexpr size_t kstepA = AT ? (size_t)BM * BK * 2 : (size_t)(BK * 2);
    const size_t hstepA = AT ? (size_t)HALF * BK * 2 : hstep;
    const size_t tstep = 2 * hstep;
    const unsigned ldsw = (unsigned)wid * 1024u;
    const int aoff = lds_byte(wr * 64 + fr, fq * 8), boff = lds_byte(wc * 32 + fr, fq * 8);
#define PG8_SA(b, h) (((b) * 2 + (h)) * HTB)
#define PG8_SB(b, h) ((4 + (b) * 2 + (h)) * HTB)
#define PG8_STAGE(bufoff, gbase, voff) do { _Pragma("unroll") for (int _i = 0; _i < 2; ++_i) \
        __builtin_amdgcn_global_load_lds((const unsigned*)((const char*)(gbase) + (voff)[_i]), (PG8_LAS unsigned*)(lds + (bufoff) + ldsw + _i * 8192), 16, 0, 0); } while (0)
#define PG8_LDA(dst, b, h) do { _Pragma("unroll") for (int m = 0; m < 4; ++m) _Pragma("unroll") for (int k = 0; k < 2; ++k) dst[m][k] = *(const PG8_LAS bf16x8*)(lds + PG8_SA(b, h) + aoff + m * 2048 + k * 1024); } while (0)
#define PG8_LDB(dst, b, h) do { _Pragma("unroll") for (int n = 0; n < 2; ++n) _Pragma("unroll") for (int k = 0; k < 2; ++k) dst[n][k] = *(const PG8_LAS bf16x8*)(lds + PG8_SB(b, h) + boff + n * 2048 + k * 1024); } while (0)
#define PG8_MMA(ai, bj, At, Bt) do { __builtin_amdgcn_s_setprio(1); _Pragma("unroll") for (int m = 0; m < 4; ++m) _Pragma("unroll") for (int n = 0; n < 2; ++n) _Pragma("unroll") for (int k = 0; k < 2; ++k) \
        acc[ai][bj][m][n] = __builtin_amdgcn_mfma_f32_16x16x32_bf16(Bt[n][k], At[m][k], acc[ai][bj][m][n], 0, 0, 0); __builtin_amdgcn_s_setprio(0); } while (0)
#define PG8_WAIT_V(n) asm volatile("s_waitcnt vmcnt(" #n ")" ::: "memory")
#define PG8_WAIT_L(n) asm volatile("s_waitcnt lgkmcnt(" #n ")" ::: "memory")
#define PG8_BAR __builtin_amdgcn_s_barrier()
#define PG8_SCHED __builtin_amdgcn_sched_barrier(0)
    Unit cur, nxt; int ui = 0;
    if (!S.next(0, cur)) return;
    f32x4 acc[2][2][4][2];
#pragma unroll
    for (int a = 0; a < 2; ++a)
#pragma unroll
        for (int b = 0; b < 2; ++b)
#pragma unroll
            for (int m = 0; m < 4; ++m)
#pragma unroll
                for (int n = 0; n < 2; ++n) acc[a][b][m][n] = (f32x4){0.f, 0.f, 0.f, 0.f};
    bf16x8 At[4][2], B0[2][2], B1[2][2];
    const char* cA = (const char*)g.A + (size_t)cur.pm * tstep; const char* cB = (const char*)g.Bt + (size_t)cur.pn * tstep;
    S.a_ready(cur);
    if constexpr (SP2) {
        PG8_STAGE(PG8_SB(0, 0), cB, voffB); PG8_STAGE(PG8_SB(0, 1), cB + hstep, voffB); PG8_STAGE(PG8_SA(0, 0), cA, voffA); PG8_STAGE(PG8_SA(0, 1), cA + hstepA, voffA);
        if (wr == 1) PG8_BAR;
        PG8_WAIT_V(2); PG8_BAR;
        PG8_STAGE(PG8_SB(1, 0), cB + kstep, voffB); PG8_STAGE(PG8_SA(1, 0), cA + kstepA, voffA); PG8_STAGE(PG8_SB(1, 1), cB + hstep + kstep, voffB);
        PG8_WAIT_V(6); PG8_BAR;
    } else {
        PG8_STAGE(PG8_SB(0, 0), cB, voffB); PG8_STAGE(PG8_SA(0, 0), cA, voffA); PG8_STAGE(PG8_SB(0, 1), cB + hstep, voffB); PG8_STAGE(PG8_SA(0, 1), cA + hstepA, voffA);
        if (wr == 1) PG8_BAR;
        PG8_WAIT_V(4); PG8_BAR;
        PG8_STAGE(PG8_SB(1, 0), cB + kstep, voffB); PG8_STAGE(PG8_SA(1, 0), cA + kstepA, voffA); PG8_STAGE(PG8_SB(1, 1), cB + hstep + kstep, voffB);
        PG8_WAIT_V(6); PG8_BAR;
    }
    for (;;) {
        const bool has_next = S.next(ui + 1, nxt);
        const char* nA = has_next ? (const char*)g.A + (size_t)nxt.pm * tstep : cA; const char* nB = has_next ? (const char*)g.Bt + (size_t)nxt.pn * tstep : cB;
        for (int t = 0; t < nt; t += 2) {
            const bool last = (t == nt - 2);
            const char* a1 = cA + (size_t)(t + 1) * kstepA;
            const char* a2 = last ? nA : cA + (size_t)(t + 2) * kstepA; const char* b2 = last ? nB : cB + (size_t)(t + 2) * kstep;
            const char* a3 = a2 + kstepA; const char* b3 = b2 + kstep;
            if (last && has_next) S.a_ready(nxt);
            if constexpr (SP2) {
            PG8_LDB(B0, 0, 0); PG8_LDB(B1, 0, 1); PG8_SCHED; PG8_LDA(At, 0, 0); PG8_STAGE(PG8_SA(1, 1), a1 + hstepA, voffA);
            PG8_WAIT_V(8); PG8_WAIT_L(0); PG8_BAR; PG8_MMA(0, 0, At, B0); PG8_MMA(0, 1, At, B1); PG8_BAR; PG8_SCHED;
            PG8_LDA(At, 0, 1); PG8_STAGE(PG8_SB(0, 0), b2, voffB); PG8_STAGE(PG8_SB(0, 1), b2 + hstep, voffB); PG8_STAGE(PG8_SA(0, 0), a2, voffA);
            PG8_WAIT_V(8); PG8_WAIT_L(0); PG8_BAR; PG8_MMA(1, 0, At, B0); PG8_MMA(1, 1, At, B1); PG8_BAR; PG8_SCHED;
            PG8_LDB(B0, 1, 0); PG8_LDB(B1, 1, 1); PG8_SCHED; PG8_LDA(At, 1, 0); PG8_STAGE(PG8_SA(0, 1), a2 + hstepA, voffA);
            PG8_WAIT_V(8); PG8_WAIT_L(0); PG8_BAR; PG8_MMA(0, 0, At, B0); PG8_MMA(0, 1, At, B1); PG8_BAR; PG8_SCHED;
            PG8_LDA(At, 1, 1); PG8_STAGE(PG8_SB(1, 0), b3, voffB); PG8_STAGE(PG8_SB(1, 1), b3 + hstep, voffB); PG8_STAGE(PG8_SA(1, 0), a3, voffA);
            PG8_WAIT_V(8); PG8_WAIT_L(0); PG8_BAR; PG8_MMA(1, 0, At, B0); PG8_MMA(1, 1, At, B1); PG8_BAR; PG8_SCHED;
            } else {
            PG8_LDB(B0, 0, 0); PG8_SCHED; PG8_LDA(At, 0, 0); PG8_STAGE(PG8_SA(1, 1), a1 + hstepA, voffA);
            PG8_WAIT_L(8); PG8_BAR; PG8_WAIT_L(0); PG8_MMA(0, 0, At, B0); PG8_BAR; PG8_SCHED;
            PG8_LDB(B1, 0, 1); PG8_STAGE(PG8_SB(0, 0), b2, voffB);
            PG8_BAR; PG8_WAIT_L(0); PG8_MMA(0, 1, At, B1); PG8_BAR;
            PG8_LDA(At, 0, 1); PG8_STAGE(PG8_SA(0, 0), a2, voffA);
            PG8_BAR; PG8_WAIT_L(0); PG8_MMA(1, 0, At, B0); PG8_BAR; PG8_SCHED;
            PG8_STAGE(PG8_SB(0, 1), b2 + hstep, voffB);
            PG8_WAIT_V(6); PG8_BAR; PG8_MMA(1, 1, At, B1); PG8_BAR;
            PG8_LDB(B0, 1, 0); PG8_SCHED; PG8_LDA(At, 1, 0); PG8_STAGE(PG8_SA(0, 1), a2 + hstepA, voffA);
            PG8_WAIT_L(8); PG8_BAR; PG8_WAIT_L(0); PG8_MMA(0, 0, At, B0); PG8_BAR; PG8_SCHED;
            PG8_LDB(B1, 1, 1); PG8_STAGE(PG8_SB(1, 0), b3, voffB);
            PG8_BAR; PG8_WAIT_L(0); PG8_MMA(0, 1, At, B1); PG8_BAR;
            PG8_LDA(At, 1, 1); PG8_STAGE(PG8_SA(1, 0), a3, voffA);
            PG8_BAR; PG8_WAIT_L(0); PG8_MMA(1, 0, At, B0); PG8_BAR; PG8_SCHED;
            PG8_STAGE(PG8_SB(1, 1), b3 + hstep, voffB);
            PG8_WAIT_V(6); PG8_BAR; PG8_MMA(1, 1, At, B1); PG8_BAR;
            }
        }
        if constexpr (ALIGN_EPI) { if (wr == 0) PG8_BAR; }
        if constexpr (!Epi::AFTER_DRAIN) { E(acc, cur, wr, wc, fr, fq); S.done(cur); }
        if (!has_next) break;
#pragma unroll
        for (int a = 0; a < 2; ++a)
#pragma unroll
            for (int b = 0; b < 2; ++b)
#pragma unroll
                for (int m = 0; m < 4; ++m)
#pragma unroll
                    for (int n = 0; n < 2; ++n) acc[a][b][m][n] = (f32x4){0.f, 0.f, 0.f, 0.f};
        cur = nxt; cA = nA; cB = nB; ++ui;
        if constexpr (ALIGN_EPI) { if (wr == 1) PG8_BAR; }
    }
    PG8_WAIT_V(0);
    if constexpr (!ALIGN_EPI) { if (wr == 0) PG8_BAR; }
    PG8_BAR;
    if constexpr (Epi::AFTER_DRAIN) { E.fused(acc, cur, wr, wc, fr, fq, lds, wid, lane); S.done(cur); }
#undef PG8_SA
#undef PG8_SB
#undef PG8_STAGE
#undef PG8_LDA
#undef PG8_LDB
#undef PG8_MMA
#undef PG8_WAIT_V
#undef PG8_WAIT_L
#undef PG8_BAR
#undef PG8_SCHED
}
}

typedef unsigned short bf16;
typedef float f32x4 __attribute__((ext_vector_type(4)));
typedef unsigned u32x4 __attribute__((ext_vector_type(4)));
typedef unsigned u32x2 __attribute__((ext_vector_type(2)));
#define LAS __attribute__((address_space(3)))
__device__ __forceinline__ float bf2f(unsigned short v) { return __uint_as_float((unsigned)v << 16); }
__device__ __forceinline__ unsigned f2bf(float f) { unsigned u = __float_as_uint(f); return (u + 0x7fffu + ((u >> 16) & 1u)) >> 16; }
__device__ __forceinline__ unsigned pk2(float lo, float hi) { return f2bf(lo) | (f2bf(hi) << 16); }
__device__ __forceinline__ float wave_sum(float v) {
#pragma unroll
    for (int o = 1; o < 64; o <<= 1) v += __shfl_xor(v, o);
    return v;
}
__device__ __forceinline__ int rel_bucket(int dist) {
    int n = dist < 0 ? 0 : dist;
    if (n < 16) return n;
    int large = 16 + (int)(logf((float)n / 16.0f) / logf(8.0f) * 16.0f);
    return large > 31 ? 31 : large;
}

__device__ __forceinline__ u32x4 pack8(const f32x4 v0, const f32x4 v1) { u32x4 w; w.x = pg8::cvt_pk_bf16(v0[0], v0[1]); w.y = pg8::cvt_pk_bf16(v0[2], v0[3]); w.z = pg8::cvt_pk_bf16(v1[0], v1[1]); w.w = pg8::cvt_pk_bf16(v1[2], v1[3]); return w; }

struct EpiNsaIn {
    static constexpr bool PERM = true, AFTER_DRAIN = false;
    bf16* Q; bf16* KV; float* GATE; LAS const float* rsl; mutable int ui;
    __device__ __forceinline__ void operator()(const f32x4 (&acc)[2][2][4][2], const pg8::Unit& u, int wr, int wc, int fr, int fq) const {
        const int row0 = u.pm * 256 + wr * 64 + fr, colt = u.pn * 256 + wc * 32 + 8 * fq;
#pragma unroll
        for (int ai = 0; ai < 2; ++ai)
#pragma unroll
            for (int m = 0; m < 4; ++m) { const int row = row0 + ai * 128 + m * 16; const float rs = rsl[ui * 256 + wr * 64 + fr + ai * 128 + m * 16];
#pragma unroll
                for (int bj = 0; bj < 2; ++bj) { const int col = colt + bj * 128;
                    f32x4 v0 = acc[ai][bj][m][0] * rs, v1 = acc[ai][bj][m][1] * rs;
                    if (col < 1024) { v0 = v0 * C2; v1 = v1 * C2; *(u32x4*)(Q + (size_t)row * D + col) = pack8(v0, v1); }
                    else { *(u32x4*)(KV + (size_t)row * KVW + (col - 1024)) = pack8(v0, v1); }
                } }
        ++ui;
    }
};
struct EpiFoxIn {
    static constexpr bool PERM = true, AFTER_DRAIN = false;
    bf16* Q; bf16* KV; float* LF; LAS const float* rsl; const float* b_f; mutable int ui;
    __device__ __forceinline__ void operator()(const f32x4 (&acc)[2][2][4][2], const pg8::Unit& u, int wr, int wc, int fr, int fq) const {
        const int row0 = u.pm * 256 + wr * 64 + fr, colt = u.pn * 256 + wc * 32 + 8 * fq;
#pragma unroll
        for (int ai = 0; ai < 2; ++ai)
#pragma unroll
            for (int m = 0; m < 4; ++m) { const int row = row0 + ai * 128 + m * 16; const float rs = rsl[ui * 256 + wr * 64 + fr + ai * 128 + m * 16];
#pragma unroll
                for (int bj = 0; bj < 2; ++bj) { const int col = colt + bj * 128;
                    f32x4 v0 = acc[ai][bj][m][0] * rs, v1 = acc[ai][bj][m][1] * rs;
                    if (col < 1024) { v0 = v0 * C2; v1 = v1 * C2; *(u32x4*)(Q + (size_t)row * D + col) = pack8(v0, v1); }
                    else { *(u32x4*)(KV + (size_t)row * FKVW + (col - 1024)) = pack8(v0, v1); }
                } }
        ++ui;
    }
};
struct EpiRelu2 {
    static constexpr bool PERM = true, AFTER_DRAIN = false;
    bf16* Hh; LAS const float* rsl; mutable int ui;
    __device__ __forceinline__ void operator()(const f32x4 (&acc)[2][2][4][2], const pg8::Unit& u, int wr, int wc, int fr, int fq) const {
        bf16* Ht = Hh + (size_t)(u.pm * (DFF / 256) + u.pn) * 65536 + (wc >> 1) * 16384 + (wr * 64 + fr) * 64 + (wc & 1) * 32 + 8 * fq;
#pragma unroll
        for (int ai = 0; ai < 2; ++ai)
#pragma unroll
            for (int m = 0; m < 4; ++m) { const int row = ai * 128 + m * 16; const float rs = rsl[ui * 256 + wr * 64 + fr + row];
#pragma unroll
                for (int bj = 0; bj < 2; ++bj) {
                    f32x4 v0 = acc[ai][bj][m][0] * rs, v1 = acc[ai][bj][m][1] * rs;
#pragma unroll
                    for (int e = 0; e < 4; ++e) { const float a = fmaxf(v0[e], 0.f), b = fmaxf(v1[e], 0.f); v0[e] = a * a; v1[e] = b * b; }
                    *(u32x4*)(Ht + bj * 32768 + row * 64) = pack8(v0, v1); } }
        ++ui;
    }
};
template <bool IN_F32> struct EpiResid {
    static constexpr bool PERM = true, AFTER_DRAIN = false;
    const float* Xin; bf16* XB; float* SSP;
    __device__ __forceinline__ void operator()(const f32x4 (&acc)[2][2][4][2], const pg8::Unit& u, int wr, int wc, int fr, int fq) const {
        const int row0 = u.pm * 256 + wr * 64 + fr, colt = u.pn * 256 + wc * 32 + 8 * fq;
#pragma unroll
        for (int ai = 0; ai < 2; ++ai)
#pragma unroll
            for (int m = 0; m < 4; ++m) { const int row = row0 + ai * 128 + m * 16; float ssq = 0.f;
#pragma unroll
                for (int bj = 0; bj < 2; ++bj) { const size_t off = (size_t)row * D + colt + bj * 128;
                    f32x4 x0, x1;
                    if (IN_F32) { x0 = *(const f32x4*)(Xin + off); x1 = *(const f32x4*)(Xin + off + 4); }
                    else { const u32x4 r4 = *(const u32x4*)(XB + off);
                        x0[0] = __uint_as_float(r4.x << 16); x0[1] = __uint_as_float(r4.x & 0xffff0000u); x0[2] = __uint_as_float(r4.y << 16); x0[3] = __uint_as_float(r4.y & 0xffff0000u);
                        x1[0] = __uint_as_float(r4.z << 16); x1[1] = __uint_as_float(r4.z & 0xffff0000u); x1[2] = __uint_as_float(r4.w << 16); x1[3] = __uint_as_float(r4.w & 0xffff0000u); }
                    x0 = x0 + acc[ai][bj][m][0]; x1 = x1 + acc[ai][bj][m][1];
                    *(u32x4*)(XB + off) = pack8(x0, x1);
                    ssq += ((x0[0] * x0[0] + x0[1] * x0[1]) + (x0[2] * x0[2] + x0[3] * x0[3])) + ((x1[0] * x1[0] + x1[1] * x1[1]) + (x1[2] * x1[2] + x1[3] * x1[3])); }
                ssq += __shfl_xor(ssq, 16); ssq += __shfl_xor(ssq, 32);
                if (fq == 0) SSP[(size_t)row * 16 + u.pn * 4 + wc] = ssq; }
    }
};

__device__ __forceinline__ void transpose_item(const float* W, const float* gain, int K, int N, bf16* WT, LAS float* scr, int item, int nblk, int lane) {
    const int kb = item / nblk, nb = item % nblk, k0 = 64 * kb, n0 = 32 * nb;
    const int nq = n0 + 4 * (lane & 7);
    f32x4 v[8];
#pragma unroll
    for (int i = 0; i < 8; ++i) { const int kk = 8 * i + (lane >> 3);
        v[i] = (f32x4){0.f, 0.f, 0.f, 0.f};
        if (nq < N) { v[i] = *(const f32x4*)(W + (size_t)(k0 + kk) * N + nq); if (gain) v[i] = v[i] * gain[k0 + kk]; } }
#pragma unroll
    for (int i = 0; i < 8; ++i) { const int kk = 8 * i + (lane >> 3); LAS float* sp = scr + kk * 33 + 4 * (lane & 7);
        sp[0] = v[i][0]; sp[1] = v[i][1]; sp[2] = v[i][2]; sp[3] = v[i][3]; }
    asm volatile("s_waitcnt lgkmcnt(0)" ::: "memory");
    const int c = lane & 7;
#pragma unroll
    for (int j = 0; j < 4; ++j) { const int n = (lane >> 3) + 8 * j; const LAS float* s = scr + (8 * c) * 33 + n;
        u32x4 o; o.x = pk2(s[0 * 33], s[1 * 33]); o.y = pk2(s[2 * 33], s[3 * 33]); o.z = pk2(s[4 * 33], s[5 * 33]); o.w = pk2(s[6 * 33], s[7 * 33]);
        *(u32x4*)(WT + (size_t)(n0 + n) * K + k0 + 8 * c) = o; }
    asm volatile("s_waitcnt lgkmcnt(0)" ::: "memory");
}
__device__ __forceinline__ void xrow4_item(const float* x, bf16* XB, float* SSP, int row0, int lane) {
    f32x4 v[4][4]; float s[4];
#pragma unroll
    for (int r = 0; r < 4; ++r) { const f32x4* xr = (const f32x4*)(x + (size_t)(row0 + r) * D) + 2 * lane;
#pragma unroll
        for (int j = 0; j < 2; ++j) { v[r][2 * j] = xr[128 * j]; v[r][2 * j + 1] = xr[128 * j + 1]; } }
#pragma unroll
    for (int r = 0; r < 4; ++r) { float a = 0.f;
#pragma unroll
        for (int j = 0; j < 4; ++j) a += (v[r][j][0] * v[r][j][0] + v[r][j][1] * v[r][j][1]) + (v[r][j][2] * v[r][j][2] + v[r][j][3] * v[r][j][3]);
        s[r] = a; }
#pragma unroll
    for (int o = 1; o < 64; o <<= 1) {
#pragma unroll
        for (int r = 0; r < 4; ++r) s[r] += __shfl_xor(s[r], o); }
#pragma unroll
    for (int r = 0; r < 4; ++r) { u32x4* o16 = (u32x4*)(XB + (size_t)(row0 + r) * D) + lane;
#pragma unroll
        for (int j = 0; j < 2; ++j) { u32x4 w; w.x = pk2(v[r][2 * j][0], v[r][2 * j][1]); w.y = pk2(v[r][2 * j][2], v[r][2 * j][3]); w.z = pk2(v[r][2 * j + 1][0], v[r][2 * j + 1][1]); w.w = pk2(v[r][2 * j + 1][2], v[r][2 * j + 1][3]); o16[64 * j] = w; } }
    const int r = lane >> 4, sl = lane & 15;
    const float sv = (r == 0) ? s[0] : (r == 1) ? s[1] : (r == 2) ? s[2] : s[3];
    SSP[(size_t)(row0 + r) * 16 + sl] = (sl == 0) ? sv : 0.f;
}

template <class Sched> __device__ __forceinline__ void rstd_prepare(LAS float* rsl, const float* SSP, const Sched& So) {
    const int tid = threadIdx.x, r = tid >> 1, half = tid & 1;
    pg8::Unit u;
    for (int i = 0; So.next(i, u); ++i) {
        const f32x4* sp = (const f32x4*)(SSP + (size_t)(u.pm * 256 + r) * 16 + half * 8);
        const f32x4 a = sp[0], c = sp[1];
        float ss = ((a[0] + a[1]) + (a[2] + a[3])) + ((c[0] + c[1]) + (c[2] + c[3]));
        ss += __shfl_xor(ss, 1);
        if (half == 0) rsl[i * 256 + r] = rsqrtf(ss * (1.0f / D) + RMS_EPS);
    }
    __syncthreads();
}

typedef short sk_bf16x8 __attribute__((ext_vector_type(8)));
template <int MODE> __device__ __forceinline__ void skinny_cols(const bf16* XB, const bf16* W, const float* SSP, const float* b_f, float* out, int gw, int NGW, int lane) {
    constexpr int NCB = (MODE == 0) ? 3 : 1, NOUT = (MODE == 0) ? 48 : 16;
    const int r16 = lane & 15, kg = lane >> 4;
    for (int task = gw; task < M / 16; task += NGW) {
        const int row0 = task * 16;
        f32x4 acc[NCB];
#pragma unroll
        for (int cb = 0; cb < NCB; ++cb) acc[cb] = (f32x4){0.f, 0.f, 0.f, 0.f};
        const bf16* ap = XB + (size_t)(row0 + r16) * D + 8 * kg;
        const bf16* bp = W + (size_t)r16 * D + 8 * kg;
#pragma unroll 8
        for (int k0 = 0; k0 < D; k0 += 32) {
            const sk_bf16x8 af = *(const sk_bf16x8*)(ap + k0);
#pragma unroll
            for (int cb = 0; cb < NCB; ++cb) { const sk_bf16x8 bf = *(const sk_bf16x8*)(bp + (size_t)cb * 16 * D + k0);
                acc[cb] = __builtin_amdgcn_mfma_f32_16x16x32_bf16(af, bf, acc[cb], 0, 0, 0); }
        }
        const f32x4* sp = (const f32x4*)(SSP + (size_t)(row0 + r16) * 16);
        const f32x4 sa = sp[0], sb = sp[1], sc = sp[2], sd = sp[3];
        const float ss = (((sa[0] + sa[1]) + (sa[2] + sa[3])) + ((sb[0] + sb[1]) + (sb[2] + sb[3]))) + (((sc[0] + sc[1]) + (sc[2] + sc[3])) + ((sd[0] + sd[1]) + (sd[2] + sd[3])));
        const float rstd = rsqrtf(ss * (1.0f / D) + RMS_EPS);
#pragma unroll
        for (int r = 0; r < 4; ++r) { const int rr = 4 * kg + r; const float rs = __shfl(rstd, rr);
#pragma unroll
            for (int cb = 0; cb < NCB; ++cb) { const int col = cb * 16 + r16; const float v = acc[cb][r] * rs;
                if (MODE == 0) out[(size_t)(row0 + rr) * NOUT + col] = 1.0f / (1.0f + __expf(-v));
                else { const float x = v + b_f[col]; out[(size_t)(row0 + rr) * NOUT + col] = fminf(x, 0.f) - log1pf(__expf(-fabsf(x))); } } }
    }
}

struct EpiFinal {
    static constexpr bool PERM = true, AFTER_DRAIN = true;
    const bf16* XB; float* out; const float* gfin; unsigned* xbuf; unsigned* cnt;
    __device__ __forceinline__ void fused(f32x4 (&acc)[2][2][4][2], const pg8::Unit& u, int wr, int wc, int fr, int fq, PG8_LAS unsigned char* lds, int wid, int lane) const {
        PG8_LAS float* P = (PG8_LAS float*)lds;
        PG8_LAS float* Sr = (PG8_LAS float*)(lds + 4096);
        const int colt = u.pn * 256 + wc * 32 + 8 * fq;
#pragma unroll
        for (int ai = 0; ai < 2; ++ai)
#pragma unroll
            for (int m = 0; m < 4; ++m) { const int rl = ai * 128 + wr * 64 + m * 16 + fr; const size_t rowoff = (size_t)(u.pm * 256 + rl) * D; float ssq = 0.f;
#pragma unroll
                for (int bj = 0; bj < 2; ++bj) { const u32x4 r4 = *(const u32x4*)(XB + rowoff + colt + bj * 128);
                    f32x4 x0 = acc[ai][bj][m][0], x1 = acc[ai][bj][m][1];
                    x0[0] += __uint_as_float(r4.x << 16); x0[1] += __uint_as_float(r4.x & 0xffff0000u); x0[2] += __uint_as_float(r4.y << 16); x0[3] += __uint_as_float(r4.y & 0xffff0000u);
                    x1[0] += __uint_as_float(r4.z << 16); x1[1] += __uint_as_float(r4.z & 0xffff0000u); x1[2] += __uint_as_float(r4.w << 16); x1[3] += __uint_as_float(r4.w & 0xffff0000u);
                    acc[ai][bj][m][0] = x0; acc[ai][bj][m][1] = x1;
                    ssq += ((x0[0] * x0[0] + x0[1] * x0[1]) + (x0[2] * x0[2] + x0[3] * x0[3])) + ((x1[0] * x1[0] + x1[1] * x1[1]) + (x1[2] * x1[2] + x1[3] * x1[3])); }
                ssq += __shfl_xor(ssq, 16); ssq += __shfl_xor(ssq, 32);
                if (fq == 0) P[rl * 4 + wc] = ssq; }
        asm volatile("s_waitcnt lgkmcnt(0)" ::: "memory"); __builtin_amdgcn_s_barrier(); asm volatile("" ::: "memory");
        const int t = wid * 64 + lane;
        if (wid < 4) {
            const f32x4 pv = *(PG8_LAS const f32x4*)(P + t * 4);
            const float tot = (pv[0] + pv[1]) + (pv[2] + pv[3]);
            __hip_atomic_store(xbuf + (size_t)(u.pm * 256 + t) * 4 + u.pn, __float_as_uint(tot), __ATOMIC_RELAXED, __HIP_MEMORY_SCOPE_AGENT);
            asm volatile("s_waitcnt vmcnt(0)" ::: "memory");
            if (lane == 0) __hip_atomic_fetch_add(cnt + 64 * u.pm, 1u, __ATOMIC_RELAXED, __HIP_MEMORY_SCOPE_AGENT);
        }
        if (wid == 0) {
            unsigned sp = 0;
            while ((unsigned)__builtin_amdgcn_readfirstlane(__hip_atomic_load(cnt + 64 * u.pm, __ATOMIC_RELAXED, __HIP_MEMORY_SCOPE_AGENT)) < 16u) { __builtin_amdgcn_s_sleep(2); if (++sp > (1u << 22)) break; }
            __builtin_amdgcn_fence(__ATOMIC_ACQUIRE, "agent");
        }
        asm volatile("s_waitcnt vmcnt(0) lgkmcnt(0)" ::: "memory"); __builtin_amdgcn_s_barrier(); asm volatile("" ::: "memory");
        if (wid < 4) {
            const unsigned* slot = xbuf + (size_t)(u.pm * 256 + t) * 4;
            const float s0 = __uint_as_float(__hip_atomic_load(slot + 0, __ATOMIC_RELAXED, __HIP_MEMORY_SCOPE_AGENT)), s1 = __uint_as_float(__hip_atomic_load(slot + 1, __ATOMIC_RELAXED, __HIP_MEMORY_SCOPE_AGENT));
            const float s2 = __uint_as_float(__hip_atomic_load(slot + 2, __ATOMIC_RELAXED, __HIP_MEMORY_SCOPE_AGENT)), s3 = __uint_as_float(__hip_atomic_load(slot + 3, __ATOMIC_RELAXED, __HIP_MEMORY_SCOPE_AGENT));
            Sr[t] = rsqrtf(((s0 + s1) + (s2 + s3)) * (1.0f / D) + RMS_EPS);
        }
        asm volatile("s_waitcnt lgkmcnt(0)" ::: "memory"); __builtin_amdgcn_s_barrier(); asm volatile("" ::: "memory");
        f32x4 gv[2][2];
#pragma unroll
        for (int bj = 0; bj < 2; ++bj)
#pragma unroll
            for (int n = 0; n < 2; ++n) gv[bj][n] = *(const f32x4*)(gfin + colt + bj * 128 + n * 4);
#pragma unroll
        for (int ai = 0; ai < 2; ++ai)
#pragma unroll
            for (int m = 0; m < 4; ++m) { const int rl = ai * 128 + wr * 64 + m * 16 + fr; const float rs = Sr[rl]; const size_t rowoff = (size_t)(u.pm * 256 + rl) * D;
#pragma unroll
                for (int bj = 0; bj < 2; ++bj)
#pragma unroll
                    for (int n = 0; n < 2; ++n) *(f32x4*)(out + rowoff + colt + bj * 128 + n * 4) = acc[ai][bj][m][n] * rs * gv[bj][n]; }
    }
};

namespace att {
typedef short bf16x8 __attribute__((ext_vector_type(8)));
typedef short s16x4 __attribute__((ext_vector_type(4)));
typedef float f32x16 __attribute__((ext_vector_type(16)));
typedef float f32x2_t __attribute__((ext_vector_type(2)));
typedef __bf16 bf16x2_t __attribute__((ext_vector_type(2)));
typedef short v4i16_t __attribute__((ext_vector_type(4)));
typedef LAS const unsigned char* lptr;
constexpr float NEG = -3.0e38f;
constexpr float THR = 8.0f;
#define WAIT_BAR() asm volatile("s_waitcnt vmcnt(0) lgkmcnt(0)\n\ts_barrier" ::: "memory")
#define LGKM0() asm volatile("s_waitcnt lgkmcnt(0)" ::: "memory")
__device__ __forceinline__ int crow(int r, int hi) { return (r & 3) + 8 * (r >> 2) + 4 * hi; }
__device__ __forceinline__ unsigned cvtpk(float lo, float hi) { f32x2_t v = {lo, hi}; bf16x2_t b = __builtin_convertvector(v, bf16x2_t); return __builtin_bit_cast(unsigned, b); }
__device__ __forceinline__ s16x4 vtr(lptr p) { return __builtin_bit_cast(s16x4, __builtin_amdgcn_ds_read_tr16_b64_v4i16((LAS v4i16_t*)p)); }
__device__ __forceinline__ float xhalf(float v) { const auto rr = __builtin_amdgcn_permlane32_swap(__float_as_uint(v), __float_as_uint(v), false, false); return __uint_as_float((threadIdx.x & 32) ? rr[0] : rr[1]); }

__device__ __forceinline__ void dma_kv(LAS unsigned char* kbuf, LAS unsigned char* vbuf, const bf16* Kg, const bf16* Vg, int pitch, int wave, int lane) {
    __builtin_amdgcn_global_load_lds((const unsigned*)(Kg + (size_t)lane * pitch + wave * 8), (LAS unsigned*)(kbuf + wave * 1024), 16, 0, 0);
    __builtin_amdgcn_global_load_lds((const unsigned*)(Vg + (size_t)(16 * (wave & 3) + (lane >> 2)) * pitch + (wave >> 2) * 32 + (lane & 3) * 8), (LAS unsigned*)(vbuf + wave * 1024), 16, 0, 0);
}
struct Acc { f32x16 o[2]; float m, l; };
__device__ __forceinline__ void acc_init(Acc& a) { a.m = -1.0e30f; a.l = 0.f;
#pragma unroll
    for (int r = 0; r < 16; ++r) { a.o[0][r] = 0.f; a.o[1][r] = 0.f; } }
__device__ __forceinline__ void qk(f32x16& p0, f32x16& p1, lptr kbuf, const bf16x8* qf, int r32, int hi) {
    lptr kb = kbuf + hi * 1024 + r32 * 16;
#pragma unroll
    for (int d0 = 0; d0 < 4; ++d0) {
        const bf16x8 b0 = *(LAS const bf16x8*)(kb + d0 * 2048);
        const bf16x8 b1 = *(LAS const bf16x8*)(kb + d0 * 2048 + 512);
        p0 = __builtin_amdgcn_mfma_f32_32x32x16_bf16(b0, qf[d0], p0, 0, 0, 0);
        p1 = __builtin_amdgcn_mfma_f32_32x32x16_bf16(b1, qf[d0], p1, 0, 0, 0);
    }
}
__device__ __forceinline__ void acc_merge(f32x16 (&res)[2], Acc& a, float gate, LAS float* wsf, int r32, int hi) {
    const float lt = a.l + xhalf(a.l);
    const float f = gate / fmaxf(lt, 1e-30f);
    LGKM0();
    if (hi == 0) wsf[r32] = f;
    LGKM0();
#pragma unroll
    for (int i = 0; i < 4; ++i) { const f32x4 fv = *(LAS const f32x4*)(wsf + 8 * i + 4 * hi);
#pragma unroll
        for (int e = 0; e < 4; ++e) { res[0][4 * i + e] += a.o[0][4 * i + e] * fv[e]; res[1][4 * i + e] += a.o[1][4 * i + e] * fv[e]; } }
    LGKM0();
}


constexpr int TLEN = 704;
__device__ __forceinline__ void gather_c(f32x16& p0, f32x16& p1, LAS const float* Tl) {
#pragma unroll
    for (int r = 0; r < 16; ++r) { const int ko = (r & 3) + 8 * (r >> 2); p0[r] = Tl[63 - ko]; p1[r] = Tl[31 - ko]; }
}
#define OPAQUE(x) asm volatile("" : "+v"(x))

__device__ __forceinline__ float gelu_tanh(float x) { float u = 0.7978845608028654f * (x + 0.044715f * x * x * x); u = fminf(fmaxf(u, -15.0f), 15.0f); const float e = __expf(2.0f * u); return 0.5f * x * (1.0f + (e - 1.0f) / (e + 1.0f)); }
__device__ __forceinline__ void compress_phase(LAS unsigned char* lds, const bf16* KV, const float* pe_k, const float* pe_v, const bf16* W1T, const float* wk2, const float* wv2, bf16* KC, bf16* VC) {
    const int tid = threadIdx.x, lane = tid & 63, wave = __builtin_amdgcn_readfirstlane(tid >> 6), r32 = lane & 31, hi = lane >> 5;
    LAS float* part = (LAS float*)lds;
    LAS float* hid = (LAS float*)(lds + 65536);
    for (int u = blockIdx.x; u < 64 * 2 * 4; u += gridDim.x) {
        const int cblk = u & 3, which = (u >> 2) & 1, bg = u >> 3, b = bg >> 2, g = bg & 3;
        const float* pe = which ? pe_v : pe_k; const float* w2 = which ? wv2 : wk2;
        const bf16* w1t = W1T + (size_t)which * 64 * 2048;
        bf16* out = which ? VC : KC;
        const int c = cblk * 32 + r32;
        f32x16 acc0, acc1;
#pragma unroll
        for (int r = 0; r < 16; ++r) { acc0[r] = 0.f; acc1[r] = 0.f; }
#pragma unroll 4
        for (int kk = 0; kk < 16; ++kk) {
            const int k0 = 256 * wave + 16 * kk, l = k0 >> 6, d = (k0 & 63) + 8 * hi;
            int tok = 16 * c + l; if (tok > S - 1) tok = S - 1;
            const u32x4 raw = *(const u32x4*)(KV + ((size_t)b * S + tok) * KVW + which * 256 + g * 64 + d);
            const f32x4 pa_ = *(const f32x4*)(pe + l * 64 + d), pb_ = *(const f32x4*)(pe + l * 64 + d + 4);
            u32x4 w;
            w.x = cvtpk(__uint_as_float(raw.x << 16) + pa_[0], __uint_as_float(raw.x & 0xffff0000u) + pa_[1]);
            w.y = cvtpk(__uint_as_float(raw.y << 16) + pa_[2], __uint_as_float(raw.y & 0xffff0000u) + pa_[3]);
            w.z = cvtpk(__uint_as_float(raw.z << 16) + pb_[0], __uint_as_float(raw.z & 0xffff0000u) + pb_[1]);
            w.w = cvtpk(__uint_as_float(raw.w << 16) + pb_[2], __uint_as_float(raw.w & 0xffff0000u) + pb_[3]);
            const bf16x8 af = __builtin_bit_cast(bf16x8, w);
            const bf16x8 b0 = *(const bf16x8*)(w1t + (size_t)r32 * 2048 + k0 + 8 * hi);
            const bf16x8 b1 = *(const bf16x8*)(w1t + (size_t)(r32 + 32) * 2048 + k0 + 8 * hi);
            acc0 = __builtin_amdgcn_mfma_f32_32x32x16_bf16(af, b0, acc0, 0, 0, 0);
            acc1 = __builtin_amdgcn_mfma_f32_32x32x16_bf16(af, b1, acc1, 0, 0, 0);
        }
        __syncthreads();
#pragma unroll
        for (int r = 0; r < 16; ++r) { LAS float* pp = part + wave * 2048 + crow(r, hi) * 64 + r32; pp[0] = acc0[r]; pp[32] = acc1[r]; }
        __syncthreads();
        const int cr = tid >> 4, n4 = (tid & 15) * 4;
        {   f32x4 sum = *(LAS const f32x4*)(part + cr * 64 + n4);
#pragma unroll
            for (int w = 1; w < 8; ++w) sum = sum + *(LAS const f32x4*)(part + w * 2048 + cr * 64 + n4);
            f32x4 hv; hv[0] = gelu_tanh(sum[0]); hv[1] = gelu_tanh(sum[1]); hv[2] = gelu_tanh(sum[2]); hv[3] = gelu_tanh(sum[3]);
            *(LAS f32x4*)(hid + cr * 64 + n4) = hv; }
        __syncthreads();
        f32x4 o = {0.f, 0.f, 0.f, 0.f};
#pragma unroll 8
        for (int i = 0; i < 64; ++i) { const float hvv = hid[cr * 64 + i]; const f32x4 wv = *(const f32x4*)(w2 + i * 64 + n4); o = o + hvv * wv; }
        const int cg_ = cblk * 32 + cr;
        if (cg_ >= NC) o = (f32x4){0.f, 0.f, 0.f, 0.f};
        u32x2 pk; pk.x = cvtpk(o[0], o[1]); pk.y = cvtpk(o[2], o[3]);
        *(u32x2*)(out + ((size_t)bg * 128 + cg_) * 64 + n4) = pk;
    }
}
#undef OPAQUE
#undef WAIT_BAR
#undef LGKM0
}

namespace att {
#define WAIT_BAR() asm volatile("s_waitcnt vmcnt(0) lgkmcnt(0)\n\ts_barrier" ::: "memory")
#define LGKM0() asm volatile("s_waitcnt lgkmcnt(0)" ::: "memory")

#undef WAIT_BAR
#undef LGKM0
}

namespace att {
#define LGKM0() asm volatile("s_waitcnt lgkmcnt(0)" ::: "memory")
template <bool MASKROWS>
__device__ __forceinline__ void exp_pack(float& lsum, f32x16& c0, f32x16& c1, bf16x8 (&pa)[4], bool okc) {
    float s0 = 0.f, s1 = 0.f;
#pragma unroll
    for (int r = 0; r < 16; ++r) { c0[r] = __builtin_amdgcn_exp2f(c0[r]); c1[r] = __builtin_amdgcn_exp2f(c1[r]); s0 += c0[r]; s1 += c1[r]; }
    const unsigned km = (MASKROWS && !okc) ? 0u : 0xffffffffu;
#pragma unroll
    for (int s = 0; s < 2; ++s) {
        u32x4 w0, w1;
        w0.x = cvtpk(c0[8 * s + 0], c0[8 * s + 1]); w0.y = cvtpk(c0[8 * s + 2], c0[8 * s + 3]); w0.z = cvtpk(c0[8 * s + 4], c0[8 * s + 5]); w0.w = cvtpk(c0[8 * s + 6], c0[8 * s + 7]);
        w1.x = cvtpk(c1[8 * s + 0], c1[8 * s + 1]); w1.y = cvtpk(c1[8 * s + 2], c1[8 * s + 3]); w1.z = cvtpk(c1[8 * s + 4], c1[8 * s + 5]); w1.w = cvtpk(c1[8 * s + 6], c1[8 * s + 7]);
        if (MASKROWS) { w0 = w0 & km; w1 = w1 & km; }
        pa[s] = __builtin_bit_cast(bf16x8, w0); pa[2 + s] = __builtin_bit_cast(bf16x8, w1);
    }
    const float st = s0 + s1;
    lsum += (MASKROWS && !okc) ? 0.f : st;
}
__device__ __forceinline__ float qnorm32(const bf16x8* qf) {
    float s = 0.f;
#pragma unroll
    for (int d0 = 0; d0 < 4; ++d0)
#pragma unroll
        for (int j = 0; j < 8; ++j) { const float v = bf2f((unsigned short)qf[d0][j]); s += v * v; }
    s += xhalf(s);
    return sqrtf(s);
}

#undef LGKM0
}

namespace att {
__device__ __forceinline__ void glds16s(unsigned voff, const void* sbase, unsigned lds_dst) { unsigned keep;
    asm volatile("s_mov_b32 %0, m0\n\ts_mov_b32 m0, %3\n\ts_nop 0\n\tglobal_load_lds_dwordx4 %1, %2\n\ts_mov_b32 m0, %0" : "=&s"(keep) : "v"(voff), "s"(sbase), "s"(lds_dst) : "memory"); }
__device__ __forceinline__ const bf16* uni(const bf16* p) {
    const unsigned long long v = (unsigned long long)p;
    const unsigned lo = __builtin_amdgcn_readfirstlane((unsigned)v), hi = __builtin_amdgcn_readfirstlane((unsigned)(v >> 32));
    return (const bf16*)(((unsigned long long)hi << 32) | lo);
}
__device__ __forceinline__ void qk4z(f32x16& p0, f32x16& p1, const unsigned (&ka)[4], const bf16x8* qf) {
    const f32x16 z = {0.f, 0.f, 0.f, 0.f, 0.f, 0.f, 0.f, 0.f, 0.f, 0.f, 0.f, 0.f, 0.f, 0.f, 0.f, 0.f};
    {   const bf16x8 b0 = *(LAS const bf16x8*)(uintptr_t)ka[0], b1 = *(LAS const bf16x8*)(uintptr_t)(ka[0] + 4096);
        p0 = __builtin_amdgcn_mfma_f32_32x32x16_bf16(b0, qf[0], z, 0, 0, 0);
        p1 = __builtin_amdgcn_mfma_f32_32x32x16_bf16(b1, qf[0], z, 0, 0, 0); }
#pragma unroll
    for (int d0 = 1; d0 < 4; ++d0) {
        const bf16x8 b0 = *(LAS const bf16x8*)(uintptr_t)ka[d0], b1 = *(LAS const bf16x8*)(uintptr_t)(ka[d0] + 4096);
        p0 = __builtin_amdgcn_mfma_f32_32x32x16_bf16(b0, qf[d0], p0, 0, 0, 0);
        p1 = __builtin_amdgcn_mfma_f32_32x32x16_bf16(b1, qf[d0], p1, 0, 0, 0);
    }
}
__device__ __forceinline__ void qk4c(f32x16& p0, f32x16& p1, const f32x16& ci0, const f32x16& ci1, const unsigned (&ka)[4], const bf16x8* qf) {
    {   const bf16x8 b0 = *(LAS const bf16x8*)(uintptr_t)ka[0], b1 = *(LAS const bf16x8*)(uintptr_t)(ka[0] + 4096);
        p0 = __builtin_amdgcn_mfma_f32_32x32x16_bf16(b0, qf[0], ci0, 0, 0, 0);
        p1 = __builtin_amdgcn_mfma_f32_32x32x16_bf16(b1, qf[0], ci1, 0, 0, 0); }
#pragma unroll
    for (int d0 = 1; d0 < 4; ++d0) {
        const bf16x8 b0 = *(LAS const bf16x8*)(uintptr_t)ka[d0], b1 = *(LAS const bf16x8*)(uintptr_t)(ka[d0] + 4096);
        p0 = __builtin_amdgcn_mfma_f32_32x32x16_bf16(b0, qf[d0], p0, 0, 0, 0);
        p1 = __builtin_amdgcn_mfma_f32_32x32x16_bf16(b1, qf[d0], p1, 0, 0, 0);
    }
}
__device__ __forceinline__ void pv4(f32x16 (&o)[2], const bf16x8 (&pa)[4], unsigned va) {
#pragma unroll
    for (int d0 = 0; d0 < 2; ++d0)
#pragma unroll
        for (int ks = 0; ks < 4; ++ks) {
            const s16x4 lo = vtr((lptr)(uintptr_t)(va + d0 * 4096 + ks * 1024)), hh = vtr((lptr)(uintptr_t)(va + d0 * 4096 + ks * 1024 + 512));
            const bf16x8 vf = (bf16x8){lo[0], lo[1], lo[2], lo[3], hh[0], hh[1], hh[2], hh[3]};
            o[d0] = __builtin_amdgcn_mfma_f32_32x32x16_bf16(pa[ks], vf, o[d0], 0, 0, 0);
        }
}


__device__ __forceinline__ void store_o_lds(const f32x16 (&res)[2], bf16* O, size_t row0, int col0, LAS unsigned short* stg, int lane, int r32, int hi) {
#pragma unroll
    for (int r = 0; r < 16; ++r) { const int orow = crow(r, hi);
        stg[orow * 64 + r32] = (unsigned short)f2bf(res[0][r]); stg[orow * 64 + 32 + r32] = (unsigned short)f2bf(res[1][r]); }
    asm volatile("s_waitcnt lgkmcnt(0)" ::: "memory");
#pragma unroll
    for (int i = 0; i < 4; ++i) { const int row = i * 8 + (lane >> 3), ch = lane & 7;
        const u32x4 v = *(LAS const u32x4*)(stg + row * 64 + ch * 8);
        *(u32x4*)(O + (row0 + row) * D + col0 + ch * 8) = v; }
    asm volatile("s_waitcnt lgkmcnt(0)" ::: "memory");
}
__device__ __forceinline__ void fox_phase4(LAS unsigned char* lds, const bf16* Q, const bf16* KV, const float* LF, bf16* O) {
    const int tid = threadIdx.x, wave = __builtin_amdgcn_readfirstlane(tid >> 6);
    const unsigned lds0 = (unsigned)(uintptr_t)lds;
    LAS unsigned char* KX = lds + 65536;
    LAS float* nc2 = (LAS float*)(lds + 98304);
    LAS float* wsf = (LAS float*)(lds + 106496) + wave * 64;
    LAS float* wt = (LAS float*)(lds + 108544);
    LAS float* wmx = wt + 16;
    for (int bh = blockIdx.x; bh < NB * NH; bh += gridDim.x) {
        const int b = bh >> 4, h = bh & 15;
        const size_t rowb = (size_t)b * S;
        const bf16* Kg = uni(KV + rowb * FKVW + h * 64); const bf16* Vg = Kg + 1024;
        float kmax;
        {   const int lane = tid & 63;
            float v[4]; float tot = 0.f, kn = 0.f;
#pragma unroll
            for (int i = 0; i < 4; ++i) { tot += LF[(rowb + 4 * tid + i) * 16 + h]; v[i] = tot;
                const u32x4* kr = (const u32x4*)(Kg + (size_t)(4 * tid + i) * FKVW); float s = 0.f;
#pragma unroll
                for (int c = 0; c < 8; ++c) { const u32x4 w = kr[c];
                    const float a0 = __uint_as_float(w.x << 16), a1 = __uint_as_float(w.x & 0xffff0000u), a2 = __uint_as_float(w.y << 16), a3 = __uint_as_float(w.y & 0xffff0000u);
                    const float a4 = __uint_as_float(w.z << 16), a5 = __uint_as_float(w.z & 0xffff0000u), a6 = __uint_as_float(w.w << 16), a7 = __uint_as_float(w.w & 0xffff0000u);
                    s += (a0 * a0 + a1 * a1) + (a2 * a2 + a3 * a3) + (a4 * a4 + a5 * a5) + (a6 * a6 + a7 * a7); }
                kn = fmaxf(kn, s); }
            float inc = tot;
#pragma unroll
            for (int o = 1; o < 64; o <<= 1) { const float n = __shfl_up(inc, o), n2 = __shfl_up(kn, o); if (lane >= o) { inc += n; kn = fmaxf(kn, n2); } }
            __syncthreads();
            if (lane == 63) { wt[wave] = inc; wmx[wave] = kn; }
            __syncthreads();
            float base = inc - tot;
            for (int w = 0; w < wave; ++w) base += wt[w];
            kn = wmx[0];
#pragma unroll
            for (int w = 1; w < 8; ++w) kn = fmaxf(kn, wmx[w]);
            kmax = sqrtf(kn);
#pragma unroll
            for (int i = 0; i < 4; ++i) { const float x = -(base + v[i]) * LOG2E; nc2[4 * tid + i] = x;
                const unsigned hb = f2bf(x); const float r1 = x - __uint_as_float(hb << 16);
                const unsigned lb = f2bf(r1); const float r2 = r1 - __uint_as_float(lb << 16);
                const unsigned llb = f2bf(r2);
                u32x4 e; e.x = hb | (lb << 16); e.y = llb | 0x3f800000u; e.z = 0u; e.w = 0u;
                *(LAS u32x4*)(KX + (size_t)(4 * tid + i) * 16) = e; }
            __syncthreads();
        }
#pragma unroll 1
        for (int qb = 7; qb >= 0; --qb) {
            int lnu_ = tid & 63; asm volatile("" : "+v"(lnu_));
            const int lane = lnu_, r32 = lnu_ & 31, hi = lnu_ >> 5;
            const int q0 = 256 * qb + 32 * wave, qpos = q0 + r32, NT = 4 * qb + 4;
            const int nact = (q0 + 31) / 64 + 1;
            bf16x8 qf[4];
#pragma unroll
            for (int d0 = 0; d0 < 4; ++d0) qf[d0] = *(const bf16x8*)(Q + (rowb + qpos) * D + h * 64 + d0 * 16 + hi * 8);
            const float mrow = qnorm32(qf) * kmax + nc2[qpos];
            const unsigned mbb = f2bf(mrow * 1.01f + 1.0f);
            u32x4 qxw; qxw.x = hi ? 0u : 0x3f803f80u; qxw.y = hi ? 0u : (0x00003f80u | ((mbb ^ 0x8000u) << 16)); qxw.z = 0u; qxw.w = 0u;
            const bf16x8 qx = __builtin_bit_cast(bf16x8, qxw);
            unsigned kofs[4];
#pragma unroll
            for (int d0 = 0; d0 < 4; ++d0) kofs[d0] = lds0 + r32 * 128 + (((2 * d0 + hi) ^ ((r32 >> 1) & 7)) << 4);
            const unsigned vbo = lds0 + 32768 + ((lane >> 4) & 1) * 32 + (lane & 3) * 8 + (4 * hi + ((lane & 15) >> 2)) * 64;
            const unsigned kxo = lds0 + 65536 + r32 * 16;
            const int krow = 8 * wave + (lane >> 3);
            const unsigned kdma = (unsigned)krow * (FKVW * 2) + (((lane & 7) ^ ((krow >> 1) & 7)) << 4);
            const unsigned vdma = (unsigned)(16 * (wave & 3) + (lane >> 2)) * (FKVW * 2) + (wave >> 2) * 64 + (lane & 3) * 16;
            const unsigned kdst = lds0 + wave * 1024, vdst = lds0 + 32768 + wave * 1024;
            Acc a; acc_init(a);
#define FOX_DMA_K(t) glds16s(kdma, Kg + (size_t)(t) * 64 * FKVW, (unsigned)__builtin_amdgcn_readfirstlane(kdst + ((t) & 3) * 8192))
#define FOX_DMA_V(t) glds16s(vdma, Vg + (size_t)(t) * 64 * FKVW, (unsigned)__builtin_amdgcn_readfirstlane(vdst + ((t) & 3) * 8192))
            if (qb == 7) {
                asm volatile("s_waitcnt vmcnt(0) lgkmcnt(0)\n\ts_barrier" ::: "memory");
                FOX_DMA_K(0); FOX_DMA_V(0); FOX_DMA_K(1); FOX_DMA_K(2); FOX_DMA_V(1);
            }
            asm volatile("s_waitcnt vmcnt(0) lgkmcnt(0)\n\ts_barrier" ::: "memory");
#define FOX_BIAS(P0, P1, t) do { const unsigned kxa = kxo + (unsigned)(t) * 1024u; \
                const bf16x8 x0 = *(LAS const bf16x8*)(uintptr_t)kxa, x1 = *(LAS const bf16x8*)(uintptr_t)(kxa + 512); \
                P0 = __builtin_amdgcn_mfma_f32_32x32x16_bf16(x0, qx, P0, 0, 0, 0); P1 = __builtin_amdgcn_mfma_f32_32x32x16_bf16(x1, qx, P1, 0, 0, 0); } while (0)
#define FOX_KA(t) unsigned ka[4]; { const unsigned so = (unsigned)((t) & 3) * 8192u; ka[0] = kofs[0] + so; ka[1] = kofs[1] + so; ka[2] = kofs[2] + so; ka[3] = kofs[3] + so; }
#define FOX_SCORES_Z(P0, P1, t) do { FOX_KA(t) qk4z(P0, P1, ka, qf); FOX_BIAS(P0, P1, t); } while (0)
#define FOX_SCORES_D(P0, P1, t) do { const int k0_ = 64 * (t); f32x16 ci0, ci1; \
                _Pragma("unroll") for (int r = 0; r < 16; ++r) { const int key = k0_ + crow(r, hi); ci0[r] = (key > qpos) ? NEG : 0.f; ci1[r] = (key + 32 > qpos) ? NEG : 0.f; } \
                FOX_KA(t) qk4c(P0, P1, ci0, ci1, ka, qf); FOX_BIAS(P0, P1, t); } while (0)
            f32x16 sA0, sA1, sB0, sB1;
            if (nact == 1) FOX_SCORES_D(sA0, sA1, 0); else FOX_SCORES_Z(sA0, sA1, 0);
#define FOX_PREFIX(j) \
            if ((j) + 2 < NT) asm volatile("s_waitcnt vmcnt(2) lgkmcnt(0)\n\ts_barrier" ::: "memory"); \
            else if ((j) + 1 < NT) asm volatile("s_waitcnt vmcnt(1) lgkmcnt(0)\n\ts_barrier" ::: "memory"); \
            else asm volatile("s_waitcnt vmcnt(0) lgkmcnt(0)\n\ts_barrier" ::: "memory");     \
            if ((j) + 3 < NT) FOX_DMA_K((j) + 3); \
            if ((j) + 2 < NT) FOX_DMA_V((j) + 2);
#define FOX_FULLZ(C0, C1, N0, N1, j) do { FOX_PREFIX(j) bf16x8 pa[4]; \
                FOX_SCORES_Z(N0, N1, (j) + 1);       \
                exp_pack<false>(a.l, C0, C1, pa, true); \
                pv4(a.o, pa, vbo + (unsigned)((j) & 3) * 8192u); } while (0)
#define FOX_FULLD(C0, C1, N0, N1, j) do { FOX_PREFIX(j) bf16x8 pa[4]; \
                FOX_SCORES_D(N0, N1, (j) + 1); \
                exp_pack<false>(a.l, C0, C1, pa, true); \
                pv4(a.o, pa, vbo + (unsigned)((j) & 3) * 8192u); } while (0)
#define FOX_TAIL(C0, C1, j) do { FOX_PREFIX(j) bf16x8 pa[4]; \
                exp_pack<false>(a.l, C0, C1, pa, true); \
                pv4(a.o, pa, vbo + (unsigned)((j) & 3) * 8192u); } while (0)
            int j = 0; const int n1 = nact - 2;
#pragma unroll 1
            for (; j + 1 < n1; j += 2) { FOX_FULLZ(sA0, sA1, sB0, sB1, j); FOX_FULLZ(sB0, sB1, sA0, sA1, j + 1); }
            if (j < n1) { FOX_FULLZ(sA0, sA1, sB0, sB1, j); sA0 = sB0; sA1 = sB1; ++j; }
            if (nact >= 2) { FOX_FULLD(sA0, sA1, sB0, sB1, j); ++j; FOX_TAIL(sB0, sB1, j); ++j; }
            else { FOX_TAIL(sA0, sA1, j); ++j; }
#pragma unroll 1
            for (; j < NT; ++j) { FOX_PREFIX(j) }
            if (qb > 0) { FOX_DMA_K(0); FOX_DMA_V(0); FOX_DMA_K(1); FOX_DMA_K(2); FOX_DMA_V(1); }
#undef FOX_FULLZ
#undef FOX_FULLD
#undef FOX_TAIL
#undef FOX_BIAS
#undef FOX_KA
#undef FOX_SCORES_Z
#undef FOX_SCORES_D
#undef FOX_PREFIX
#undef FOX_DMA_K
#undef FOX_DMA_V
            f32x16 res[2];
#pragma unroll
            for (int r = 0; r < 16; ++r) { res[0][r] = 0.f; res[1][r] = 0.f; }
            acc_merge(res, a, 1.0f, wsf, r32, hi);
            store_o_lds(res, O, rowb + q0, h * 64, (LAS unsigned short*)(lds + 110592) + wave * 2048, lane, r32, hi);
        }
    }
}

__device__ __forceinline__ void fox_phase5(LAS unsigned char* lds, const bf16* Q, const bf16* KV, const float* LF, bf16* O) {
    const int tid = threadIdx.x, wave = __builtin_amdgcn_readfirstlane(tid >> 6);
    const unsigned lds0 = (unsigned)(uintptr_t)lds;
    LAS unsigned char* KX = lds + 65536;
    LAS float* nc2 = (LAS float*)(lds + 98304);
    LAS float* wsf = (LAS float*)(lds + 106496) + wave * 64;
    LAS float* wt = (LAS float*)(lds + 108544);
    LAS float* wmx = wt + 16;
    for (int bh = blockIdx.x; bh < NB * NH; bh += gridDim.x) {
        const int b = bh >> 4, h = bh & 15;
        const size_t rowb = (size_t)b * S;
        const bf16* Kg = uni(KV + rowb * FKVW + h * 64); const bf16* Vg = Kg + 1024;
        float kmax;
        {   int tidl = tid; asm volatile("" : "+v"(tidl));
            const int lane = tidl & 63;
            float v[4]; float tot = 0.f, kn = 0.f;
#pragma unroll
            for (int i = 0; i < 4; ++i) { tot += LF[(rowb + 4 * tidl + i) * 16 + h]; v[i] = tot;
                const u32x4* kr = (const u32x4*)(Kg + (size_t)(4 * tidl + i) * FKVW); float s = 0.f;
#pragma unroll
                for (int c = 0; c < 8; ++c) { const u32x4 w = kr[c];
                    const float a0 = __uint_as_float(w.x << 16), a1 = __uint_as_float(w.x & 0xffff0000u), a2 = __uint_as_float(w.y << 16), a3 = __uint_as_float(w.y & 0xffff0000u);
                    const float a4 = __uint_as_float(w.z << 16), a5 = __uint_as_float(w.z & 0xffff0000u), a6 = __uint_as_float(w.w << 16), a7 = __uint_as_float(w.w & 0xffff0000u);
                    s += (a0 * a0 + a1 * a1) + (a2 * a2 + a3 * a3) + (a4 * a4 + a5 * a5) + (a6 * a6 + a7 * a7); }
                kn = fmaxf(kn, s); }
            float inc = tot;
#pragma unroll
            for (int o = 1; o < 64; o <<= 1) { const float n = __shfl_up(inc, o), n2 = __shfl_up(kn, o); if (lane >= o) { inc += n; kn = fmaxf(kn, n2); } }
            __syncthreads();
            if (lane == 63) { wt[wave] = inc; wmx[wave] = kn; }
            __syncthreads();
            float base = inc - tot;
            for (int w = 0; w < wave; ++w) base += wt[w];
            kn = wmx[0];
#pragma unroll
            for (int w = 1; w < 8; ++w) kn = fmaxf(kn, wmx[w]);
            kmax = sqrtf(kn);
#pragma unroll
            for (int i = 0; i < 4; ++i) { const float x = -(base + v[i]) * LOG2E; nc2[4 * tidl + i] = x;
                const unsigned hb = f2bf(x); const float r1 = x - __uint_as_float(hb << 16);
                const unsigned lb = f2bf(r1); const float r2 = r1 - __uint_as_float(lb << 16);
                const unsigned llb = f2bf(r2);
                u32x4 e; e.x = hb | (lb << 16); e.y = llb | 0x3f800000u; e.z = 0u; e.w = 0u;
                *(LAS u32x4*)(KX + (size_t)(4 * tidl + i) * 16) = e; }
            __syncthreads();
        }
#pragma unroll 1
        for (int qb = 3; qb >= 0; --qb) {
            int lnu_ = tid & 63; asm volatile("" : "+v"(lnu_));
            const int lane = lnu_, r32 = lnu_ & 31, hi = lnu_ >> 5;
            const int q0 = 512 * qb + 64 * wave, qposA = q0 + r32, qposB = qposA + 32, NT = 8 * qb + 8;
            const int nact = 8 * qb + wave + 1;
            bf16x8 qfA[4], qfB[4];
#pragma unroll
            for (int d0 = 0; d0 < 4; ++d0) { qfA[d0] = *(const bf16x8*)(Q + (rowb + qposA) * D + h * 64 + d0 * 16 + hi * 8); qfB[d0] = *(const bf16x8*)(Q + (rowb + qposB) * D + h * 64 + d0 * 16 + hi * 8); }
            const unsigned mbA = f2bf((qnorm32(qfA) * kmax + nc2[qposA]) * 1.01f + 1.0f), mbB = f2bf((qnorm32(qfB) * kmax + nc2[qposB]) * 1.01f + 1.0f);
            u32x4 qxw; qxw.x = hi ? 0u : 0x3f803f80u; qxw.y = hi ? 0u : (0x00003f80u | ((mbA ^ 0x8000u) << 16)); qxw.z = 0u; qxw.w = 0u;
            const bf16x8 qxA = __builtin_bit_cast(bf16x8, qxw);
            qxw.y = hi ? 0u : (0x00003f80u | ((mbB ^ 0x8000u) << 16));
            const bf16x8 qxB = __builtin_bit_cast(bf16x8, qxw);
            unsigned kofs[4];
#pragma unroll
            for (int d0 = 0; d0 < 4; ++d0) kofs[d0] = lds0 + r32 * 128 + (((2 * d0 + hi) ^ ((r32 >> 1) & 7)) << 4);
            const unsigned vbo = lds0 + 32768 + ((lane >> 4) & 1) * 32 + (lane & 3) * 8 + (4 * hi + ((lane & 15) >> 2)) * 64;
            const unsigned kxo = lds0 + 65536 + r32 * 16;
            const int krow = 8 * wave + (lane >> 3);
            const unsigned kdma = (unsigned)krow * (FKVW * 2) + (((lane & 7) ^ ((krow >> 1) & 7)) << 4);
            const unsigned vdma = (unsigned)(16 * (wave & 3) + (lane >> 2)) * (FKVW * 2) + (wave >> 2) * 64 + (lane & 3) * 16;
            const unsigned kdst = lds0 + wave * 1024, vdst = lds0 + 32768 + wave * 1024;
            Acc aA, aB; acc_init(aA); acc_init(aB);
#define FOX_DMA_K(t) glds16s(kdma, Kg + (size_t)(t) * 64 * FKVW, (unsigned)__builtin_amdgcn_readfirstlane(kdst + ((t) & 3) * 8192))
#define FOX_DMA_V(t) glds16s(vdma, Vg + (size_t)(t) * 64 * FKVW, (unsigned)__builtin_amdgcn_readfirstlane(vdst + ((t) & 3) * 8192))
            asm volatile("s_waitcnt vmcnt(0) lgkmcnt(0)\n\ts_barrier" ::: "memory");
            FOX_DMA_K(0); FOX_DMA_V(0); FOX_DMA_K(1); FOX_DMA_V(1);
#define FOX_PREFIX(t) \
            if ((t) + 1 < NT) asm volatile("s_waitcnt vmcnt(2) lgkmcnt(0)\n\ts_barrier" ::: "memory"); \
            else asm volatile("s_waitcnt vmcnt(0) lgkmcnt(0)\n\ts_barrier" ::: "memory");     \
            if ((t) + 2 < NT) { FOX_DMA_K((t) + 2); FOX_DMA_V((t) + 2); }
#define FOX_STEP(t, DIAG) do { \
            const unsigned so = (unsigned)((t) & 3) * 8192u; \
            const unsigned kxa = kxo + (unsigned)(t) * 1024u; \
            const bf16x8 x0 = *(LAS const bf16x8*)(uintptr_t)kxa, x1 = *(LAS const bf16x8*)(uintptr_t)(kxa + 512); \
            f32x16 a0, a1, b0, b1; \
            if (DIAG) { const int k0_ = 64 * (t); \
                _Pragma("unroll") for (int r = 0; r < 16; ++r) { const int key = k0_ + crow(r, hi); a0[r] = (key > qposA) ? NEG : 0.f; a1[r] = (key + 32 > qposA) ? NEG : 0.f; b0[r] = (key > qposB) ? NEG : 0.f; b1[r] = (key + 32 > qposB) ? NEG : 0.f; } } \
            else { _Pragma("unroll") for (int r = 0; r < 16; ++r) { a0[r] = 0.f; a1[r] = 0.f; b0[r] = 0.f; b1[r] = 0.f; } } \
            _Pragma("unroll") for (int d0 = 0; d0 < 4; ++d0) { \
                const bf16x8 k0f = *(LAS const bf16x8*)(uintptr_t)(kofs[d0] + so), k1f = *(LAS const bf16x8*)(uintptr_t)(kofs[d0] + so + 4096); \
                a0 = __builtin_amdgcn_mfma_f32_32x32x16_bf16(k0f, qfA[d0], a0, 0, 0, 0); a1 = __builtin_amdgcn_mfma_f32_32x32x16_bf16(k1f, qfA[d0], a1, 0, 0, 0); \
                b0 = __builtin_amdgcn_mfma_f32_32x32x16_bf16(k0f, qfB[d0], b0, 0, 0, 0); b1 = __builtin_amdgcn_mfma_f32_32x32x16_bf16(k1f, qfB[d0], b1, 0, 0, 0); } \
            a0 = __builtin_amdgcn_mfma_f32_32x32x16_bf16(x0, qxA, a0, 0, 0, 0); a1 = __builtin_amdgcn_mfma_f32_32x32x16_bf16(x1, qxA, a1, 0, 0, 0); \
            b0 = __builtin_amdgcn_mfma_f32_32x32x16_bf16(x0, qxB, b0, 0, 0, 0); b1 = __builtin_amdgcn_mfma_f32_32x32x16_bf16(x1, qxB, b1, 0, 0, 0); \
            bf16x8 paA[4], paB[4]; \
            exp_pack<false>(aA.l, a0, a1, paA, true); \
            exp_pack<false>(aB.l, b0, b1, paB, true); \
            const unsigned va = vbo + so; \
            _Pragma("unroll") for (int d0 = 0; d0 < 2; ++d0) _Pragma("unroll") for (int ks = 0; ks < 4; ++ks) { \
                const s16x4 lo = vtr((lptr)(uintptr_t)(va + d0 * 4096 + ks * 1024)), hh = vtr((lptr)(uintptr_t)(va + d0 * 4096 + ks * 1024 + 512)); \
                const bf16x8 vf = (bf16x8){lo[0], lo[1], lo[2], lo[3], hh[0], hh[1], hh[2], hh[3]}; \
                aA.o[d0] = __builtin_amdgcn_mfma_f32_32x32x16_bf16(paA[ks], vf, aA.o[d0], 0, 0, 0); \
                aB.o[d0] = __builtin_amdgcn_mfma_f32_32x32x16_bf16(paB[ks], vf, aB.o[d0], 0, 0, 0); } } while (0)
            int t = 0;
#pragma unroll 1
            for (; t + 1 < nact; ++t) { FOX_PREFIX(t) FOX_STEP(t, false); }
            { FOX_PREFIX(t) FOX_STEP(t, true); ++t; }
#pragma unroll 1
            for (; t < NT; ++t) { FOX_PREFIX(t) }
#undef FOX_STEP
#undef FOX_PREFIX
#undef FOX_DMA_K
#undef FOX_DMA_V
            LAS unsigned short* stg = (LAS unsigned short*)(lds + 110592) + wave * 2048;
            f32x16 res[2];
#pragma unroll
            for (int r = 0; r < 16; ++r) { res[0][r] = 0.f; res[1][r] = 0.f; }
            acc_merge(res, aA, 1.0f, wsf, r32, hi);
            store_o_lds(res, O, rowb + q0, h * 64, stg, lane, r32, hi);
#pragma unroll
            for (int r = 0; r < 16; ++r) { res[0][r] = 0.f; res[1][r] = 0.f; }
            acc_merge(res, aB, 1.0f, wsf, r32, hi);
            store_o_lds(res, O, rowb + q0 + 32, h * 64, stg, lane, r32, hi);
        }
    }
}

#define WAIT_BAR() asm volatile("s_waitcnt vmcnt(0) lgkmcnt(0)\n\ts_barrier" ::: "memory")
#define LGKM0() asm volatile("s_waitcnt lgkmcnt(0)" ::: "memory")
__device__ __forceinline__ void nsa_phase4(LAS unsigned char* lds, const bf16* Q, const bf16* KV, const bf16* KC, const bf16* VC, const float* GATE, const float* TBL, bf16* O) {
    const int tid0 = threadIdx.x, wave = __builtin_amdgcn_readfirstlane(tid0 >> 6);
    const int hh = wave >> 1, rhalf = wave & 1;
    const unsigned lds0 = (unsigned)(uintptr_t)lds;
    LAS float* T = (LAS float*)(lds + 65536);
    LAS float* wsf0 = (LAS float*)(lds + 77824) + wave * 64;
    LAS float* score = (LAS float*)(lds + 79872);
    LAS unsigned* maskl = (LAS unsigned*)(lds + 88064);
    LAS unsigned char* park0 = lds + 90112 + wave * 8192;
    LAS float* imph_w = (LAS float*)(lds + 90112 + hh * 8192);
    const int Gd = gridDim.x;
    const bool bal = (Gd == 256);
    const int vc = bal ? ((blockIdx.x & 7) * 32 + (blockIdx.x >> 3)) : (int)blockIdx.x;
    const int nun = bal ? 8 : (2048 - vc + Gd - 1) / Gd;
    int gcur = -1, bgcur = -1;
    float bmaxw = 0.f, kmax_sel = 0.f, kmax_win = 0.f;
    for (int ui = 0; ui < nun; ++ui) {
        int tid = tid0; asm volatile("" : "+v"(tid));
        const int lane = tid & 63, r32 = lane & 31, hi = lane >> 5;
        LAS float* wsf = wsf0; LAS unsigned char* park = park0;
        int bg, qb;
        if (bal) { bg = vc >> 2; const int sub = vc & 3, pr = ui >> 1; qb = 8 * pr + ((ui & 1) ? (7 - sub) : sub); }
        else { const int u = vc + ui * Gd; bg = u >> 5; qb = u & 31; }
        const int b = bg >> 2, g = bg & 3, head = 4 * g + hh;
        const size_t rowb = (size_t)b * S;
        const int q0 = 64 * qb + 32 * rhalf, qpos = q0 + r32;
        const bf16* Ksel = uni(KV + rowb * KVW + 2 * 256 + g * 64); const bf16* Kwin = Ksel + 2 * 256;
        WAIT_BAR();
        if (g != gcur) { for (int i = tid; i < 4 * TLEN; i += 512) T[i] = TBL[g * 4 * TLEN + i]; }
        if (bg != bgcur) {
            float ks = 0.f, kw = 0.f;
#pragma unroll
            for (int i = 0; i < 4; ++i) { const u32x4* k1 = (const u32x4*)(Ksel + (size_t)(4 * tid + i) * KVW); const u32x4* k2 = (const u32x4*)(Kwin + (size_t)(4 * tid + i) * KVW); float s1 = 0.f, s2 = 0.f;
#pragma unroll
                for (int c = 0; c < 8; ++c) { const u32x4 w = k1[c], x = k2[c];
                    { const float a0 = __uint_as_float(w.x << 16), a1 = __uint_as_float(w.x & 0xffff0000u), a2 = __uint_as_float(w.y << 16), a3 = __uint_as_float(w.y & 0xffff0000u);
                      const float a4 = __uint_as_float(w.z << 16), a5 = __uint_as_float(w.z & 0xffff0000u), a6 = __uint_as_float(w.w << 16), a7 = __uint_as_float(w.w & 0xffff0000u);
                      s1 += (a0 * a0 + a1 * a1) + (a2 * a2 + a3 * a3) + (a4 * a4 + a5 * a5) + (a6 * a6 + a7 * a7); }
                    { const float a0 = __uint_as_float(x.x << 16), a1 = __uint_as_float(x.x & 0xffff0000u), a2 = __uint_as_float(x.y << 16), a3 = __uint_as_float(x.y & 0xffff0000u);
                      const float a4 = __uint_as_float(x.z << 16), a5 = __uint_as_float(x.z & 0xffff0000u), a6 = __uint_as_float(x.w << 16), a7 = __uint_as_float(x.w & 0xffff0000u);
                      s2 += (a0 * a0 + a1 * a1) + (a2 * a2 + a3 * a3) + (a4 * a4 + a5 * a5) + (a6 * a6 + a7 * a7); } }
                ks = fmaxf(ks, s1); kw = fmaxf(kw, s2); }
#pragma unroll
            for (int o = 1; o < 64; o <<= 1) { const float n1 = __shfl_up(ks, o), n2 = __shfl_up(kw, o); if (lane >= o) { ks = fmaxf(ks, n1); kw = fmaxf(kw, n2); } }
            if (lane == 63) { score[wave] = ks; score[8 + wave] = kw; }
            WAIT_BAR();
            ks = score[0]; kw = score[8];
#pragma unroll
            for (int w = 1; w < 8; ++w) { ks = fmaxf(ks, score[w]); kw = fmaxf(kw, score[8 + w]); }
            kmax_sel = sqrtf(ks); kmax_win = sqrtf(kw);
            bgcur = bg;
        }
        const int ncmp = (qb >= 16) ? 2 : 1;
        const bf16* kcg = KC + (size_t)bg * 128 * 64; const bf16* vcg = VC + (size_t)bg * 128 * 64;
        dma_kv(lds + 16384, lds + 32768 + 16384, kcg, vcg, 64, wave, lane);
        if (ncmp == 2) dma_kv(lds + 24576, lds + 32768 + 24576, kcg + 64 * 64, vcg + 64 * 64, 64, wave, lane);
        const int NSEL = qb + 1, jlo = (qb >= 8) ? qb - 8 : 0, NT = NSEL + (qb - jlo + 1);
        const int krow = 8 * wave + (lane >> 3);
        const unsigned kdma = (unsigned)krow * (KVW * 2) + (((lane & 7) ^ ((krow >> 1) & 7)) << 4);
        const unsigned vdma = (unsigned)(16 * (wave & 3) + (lane >> 2)) * (KVW * 2) + (wave >> 2) * 64 + (lane & 3) * 16;
        const unsigned kdst = lds0 + wave * 1024, vdst = lds0 + 32768 + wave * 1024;
#define NSA_KBASE(n) (((n) < NSEL) ? Ksel + (size_t)(n) * 64 * KVW : Kwin + (size_t)(jlo + (n) - NSEL) * 64 * KVW)
#define NSA_DMA_K(n) do { const bf16* kb_ = NSA_KBASE(n); glds16s(kdma, kb_, (unsigned)__builtin_amdgcn_readfirstlane(kdst + ((n) & 3) * 8192)); } while (0)
#define NSA_DMA_V(n) do { const bf16* kb_ = NSA_KBASE(n); glds16s(vdma, kb_ + 256, (unsigned)__builtin_amdgcn_readfirstlane(vdst + ((n) & 3) * 8192)); } while (0)
        NSA_DMA_K(0); NSA_DMA_V(0); NSA_DMA_K(1); NSA_DMA_V(1);
        bf16x8 qf[4];
#pragma unroll
        for (int d0 = 0; d0 < 4; ++d0) qf[d0] = *(const bf16x8*)(Q + (rowb + qpos) * D + head * 64 + d0 * 16 + hi * 8);
        const float* gp = GATE + (rowb + qpos) * 48 + head;
        const float g0 = gp[0], g1 = gp[16], g2 = gp[32];
        f32x16 res[2];
#pragma unroll
        for (int r = 0; r < 16; ++r) { res[0][r] = 0.f; res[1][r] = 0.f; }
        LAS const float* Th = T + hh * TLEN;
        WAIT_BAR();
        if (g != gcur) {
            float bm = fmaxf(fmaxf(Th[63 + lane], Th[127 + lane]), 0.f);
#pragma unroll
            for (int o = 1; o < 64; o <<= 1) { const float n1 = __shfl_up(bm, o); if (lane >= o) bm = fmaxf(bm, n1); }
            bmaxw = __shfl(bm, 63);
            gcur = g;
        }
        {
            f32x16 p0, p1;
#define CMP_SCORES(tile) do { _Pragma("unroll") for (int r = 0; r < 16; ++r) { const int c = crow(r, hi); \
                int da = qpos - 16 * c - 31 - 1024 * (tile), db = da - 512; \
                da = da < -63 ? -63 : (da > 128 ? 128 : da); db = db < -63 ? -63 : (db > 128 ? 128 : db); \
                p0[r] = Th[da + 63]; p1[r] = Th[db + 63]; } \
                qk(p0, p1, lds + 16384 + (tile) * 8192, qf, r32, hi); } while (0)
            float rm = NEG;
            CMP_SCORES(0);
#pragma unroll
            for (int r = 0; r < 16; ++r) rm = fmaxf(rm, fmaxf(p0[r], p1[r]));
            if (ncmp == 2) {
                CMP_SCORES(1);
#pragma unroll
                for (int r = 0; r < 16; ++r) rm = fmaxf(rm, fmaxf(p0[r], p1[r]));
            }
            rm = fmaxf(rm, xhalf(rm));
            const float mm = fmaxf(rm, -1.0e30f);
            float sum = 0.f, tBprev = 0.f;
            float impv[16];
            Acc a; acc_init(a);
            lptr vb = lds + 32768 + 16384 + ((lane >> 4) & 1) * 32 + (lane & 3) * 8 + (4 * hi + ((lane & 15) >> 2)) * 64;
#define IMP_GROUP(P, i, n) do { const float e0 = P[4 * (i)], e1 = P[4 * (i) + 1], e2 = P[4 * (i) + 2], e3 = P[4 * (i) + 3]; \
                const float A = 2.0f * (e0 + e1 + e2) + e3; const float tB = xhalf(e3); \
                impv[n] = A + (hi ? tB : tBprev); tBprev = tB; } while (0)
#define CMP_PASS2(tile) do { \
                _Pragma("unroll") for (int r = 0; r < 16; ++r) { p0[r] = __builtin_amdgcn_exp2f(p0[r] - mm); p1[r] = __builtin_amdgcn_exp2f(p1[r] - mm); sum += p0[r] + p1[r]; } \
                if (qb >= 16) { _Pragma("unroll") for (int i = 0; i < 4; ++i) IMP_GROUP(p0, i, 8 * (tile) + i); \
                _Pragma("unroll") for (int i = 0; i < 4; ++i) IMP_GROUP(p1, i, 8 * (tile) + 4 + i); } \
                bf16x8 pa[4]; \
                _Pragma("unroll") for (int s2 = 0; s2 < 2; ++s2) { u32x4 w0, w1; \
                    w0.x = cvtpk(p0[8 * s2 + 0], p0[8 * s2 + 1]); w0.y = cvtpk(p0[8 * s2 + 2], p0[8 * s2 + 3]); w0.z = cvtpk(p0[8 * s2 + 4], p0[8 * s2 + 5]); w0.w = cvtpk(p0[8 * s2 + 6], p0[8 * s2 + 7]); \
                    w1.x = cvtpk(p1[8 * s2 + 0], p1[8 * s2 + 1]); w1.y = cvtpk(p1[8 * s2 + 2], p1[8 * s2 + 3]); w1.z = cvtpk(p1[8 * s2 + 4], p1[8 * s2 + 5]); w1.w = cvtpk(p1[8 * s2 + 6], p1[8 * s2 + 7]); \
                    pa[s2] = __builtin_bit_cast(bf16x8, w0); pa[2 + s2] = __builtin_bit_cast(bf16x8, w1); } \
                _Pragma("unroll") for (int d0 = 0; d0 < 2; ++d0) \
                _Pragma("unroll") for (int ks = 0; ks < 4; ++ks) { const s16x4 lo = vtr(vb + (tile) * 8192 + d0 * 4096 + ks * 1024), hv = vtr(vb + (tile) * 8192 + d0 * 4096 + ks * 1024 + 512); \
                    const bf16x8 vf = (bf16x8){lo[0], lo[1], lo[2], lo[3], hv[0], hv[1], hv[2], hv[3]}; \
                    a.o[d0] = __builtin_amdgcn_mfma_f32_32x32x16_bf16(pa[ks], vf, a.o[d0], 0, 0, 0); } } while (0)
            if (ncmp == 2) { CMP_SCORES(0); }
            CMP_PASS2(0);
            if (ncmp == 2) { CMP_SCORES(1); CMP_PASS2(1); }
            else {
#pragma unroll
                for (int n = 8; n < 16; ++n) impv[n] = 0.f;
            }
#undef CMP_SCORES
#undef IMP_GROUP
#undef CMP_PASS2
            const float lt = sum + xhalf(sum), inv = 1.0f / fmaxf(lt, 1e-30f);
            LAS float* ip = imph_w + (size_t)(rhalf * 32 + r32) * 32 + hi;
            if (qb >= 16) {
#pragma unroll
                for (int n = 0; n < 16; ++n) ip[2 * n] = impv[n] * inv;
            }
            a.l = 0.5f * lt;
            acc_merge(res, a, g0, wsf, r32, hi);
        }
        if (qb >= 16) WAIT_BAR();
        if (qb >= 16) {
            int tk = tid; asm volatile("" : "+v"(tk));
            const int row = tk >> 3, part = tk & 7;
            LAS const float* i0 = (LAS const float*)(lds + 90112) + row * 32, * i1 = (LAS const float*)(lds + 98304) + row * 32, * i2 = (LAS const float*)(lds + 106496) + row * 32, * i3 = (LAS const float*)(lds + 114688) + row * 32;
            u32x4 kc;
#pragma unroll
            for (int e = 0; e < 4; ++e) { const int j = 4 * part + e;
                const float sj = ((i0[j] + i1[j]) + i2[j]) + i3[j];
                const bool visible = j <= qb, forced = (j == 0) || (j == qb) || (j == qb - 1);
                const float scv = visible ? (forced ? 1.0e9f : sj) : -1.0e30f;
                const unsigned ub = __float_as_uint(scv), so = (ub & 0x80000000u) ? ~ub : (ub | 0x80000000u);
                kc[e] = (so & ~31u) | (unsigned)(31 - j); }
            LAS unsigned* skey = (LAS unsigned*)score;
            *(LAS u32x4*)(skey + row * 32 + 4 * part) = kc;
            LGKM0();
            int rk0 = 0, rk1 = 0, rk2 = 0, rk3 = 0;
#pragma unroll
            for (int i4 = 0; i4 < 8; ++i4) { const u32x4 o4 = *(LAS const u32x4*)(skey + row * 32 + 4 * i4);
#pragma unroll
                for (int e = 0; e < 4; ++e) { const unsigned ki = o4[e];
                    rk0 += (ki > kc[0]) ? 1 : 0; rk1 += (ki > kc[1]) ? 1 : 0; rk2 += (ki > kc[2]) ? 1 : 0; rk3 += (ki > kc[3]) ? 1 : 0; } }
            unsigned nib = (rk0 < 16 ? 1u : 0u) | (rk1 < 16 ? 2u : 0u) | (rk2 < 16 ? 4u : 0u) | (rk3 < 16 ? 8u : 0u);
            unsigned mk = nib << (4 * part);
            mk |= __shfl_xor(mk, 1); mk |= __shfl_xor(mk, 2); mk |= __shfl_xor(mk, 4);
            if (part == 0) maskl[row] = mk;
        }
        unsigned mymask = 0xffffffffu;
        if (qb >= 16) { asm volatile("s_waitcnt lgkmcnt(0)\n\ts_barrier" ::: "memory");
            mymask = maskl[rhalf * 32 + r32]; }
        const float qn = qnorm32(qf);
        const unsigned mbs = (f2bf((qn * kmax_sel + bmaxw) * 1.01f + 1.0f) ^ 0x8000u), mbw = (f2bf((qn * kmax_win + bmaxw) * 1.01f + 1.0f) ^ 0x8000u);
        u32x4 kx1w; kx1w.x = 0x00003f80u; kx1w.y = 0u; kx1w.z = 0u; kx1w.w = 0u;
        const bf16x8 kx1 = __builtin_bit_cast(bf16x8, kx1w);
        unsigned kofs[4];
#pragma unroll
        for (int d0 = 0; d0 < 4; ++d0) kofs[d0] = lds0 + r32 * 128 + (((2 * d0 + hi) ^ ((r32 >> 1) & 7)) << 4);
        const unsigned vbo = lds0 + 32768 + ((lane >> 4) & 1) * 32 + (lane & 3) * 8 + (4 * hi + ((lane & 15) >> 2)) * 64;
        LAS const float* Tq = Th + (q0 + r32) - 4 * hi;
#define NSA_QX(n) u32x4 qxw_; { const bool sel_ = (n) < NSEL; const int j_ = sel_ ? (n) : jlo + (n) - NSEL; const bool ok_ = sel_ ? (((mymask >> j_) & 1u) != 0u) : true; \
            qxw_.x = hi ? 0u : (ok_ ? (sel_ ? mbs : mbw) : 0xff00u); qxw_.y = 0u; qxw_.z = 0u; qxw_.w = 0u; } const bf16x8 qx_ = __builtin_bit_cast(bf16x8, qxw_);
#define NSA_KA(n) unsigned ka[4]; { const unsigned so = (unsigned)((n) & 3) * 8192u; ka[0] = kofs[0] + so; ka[1] = kofs[1] + so; ka[2] = kofs[2] + so; ka[3] = kofs[3] + so; }
#define NSA_ISNEAR(n) ((((n) < NSEL) ? 64 * (n) : 64 * (jlo + (n) - NSEL)) + 63 + 128 > q0 || ((n) >= NSEL && jlo + (n) - NSEL == qb - 8))
#define NSA_SCORES_Z(P0, P1, n) do { NSA_QX(n) NSA_KA(n) qk4z(P0, P1, ka, qf); \
            P0 = __builtin_amdgcn_mfma_f32_32x32x16_bf16(kx1, qx_, P0, 0, 0, 0); P1 = __builtin_amdgcn_mfma_f32_32x32x16_bf16(kx1, qx_, P1, 0, 0, 0); } while (0)
#define NSA_SCORES_G(P0, P1, n) do { NSA_QX(n) NSA_KA(n) const int k0_ = ((n) < NSEL) ? 64 * (n) : 64 * (jlo + (n) - NSEL); f32x16 ci0, ci1; gather_c(ci0, ci1, Tq - k0_); \
            qk4c(P0, P1, ci0, ci1, ka, qf); \
            P0 = __builtin_amdgcn_mfma_f32_32x32x16_bf16(kx1, qx_, P0, 0, 0, 0); P1 = __builtin_amdgcn_mfma_f32_32x32x16_bf16(kx1, qx_, P1, 0, 0, 0); } while (0)
        Acc a; acc_init(a);
#define NSA_PREFIX(n) \
        if ((n) + 1 < NT) asm volatile("s_waitcnt vmcnt(2) lgkmcnt(0)\n\ts_barrier" ::: "memory"); \
        else asm volatile("s_waitcnt vmcnt(0) lgkmcnt(0)\n\ts_barrier" ::: "memory");     \
        if ((n) + 2 < NT) { NSA_DMA_K((n) + 2); NSA_DMA_V((n) + 2); } \
        if ((n) == NSEL) { acc_merge(res, a, g1, wsf, r32, hi); acc_init(a); }
#pragma unroll 1
        for (int n = 0; n < NT; ++n) {
            NSA_PREFIX(n)
            f32x16 c0, c1; bf16x8 pa[4];
            if (!NSA_ISNEAR(n)) {
                NSA_SCORES_Z(c0, c1, n);
                exp_pack<false>(a.l, c0, c1, pa, true);
                pv4(a.o, pa, vbo + (unsigned)(n & 3) * 8192u);
            } else {
                NSA_SCORES_G(c0, c1, n);
                exp_pack<false>(a.l, c0, c1, pa, true);
                pv4(a.o, pa, vbo + (unsigned)(n & 3) * 8192u);
            }
        }
#undef NSA_PREFIX
#undef NSA_SCORES_Z
#undef NSA_SCORES_G
#undef NSA_ISNEAR
#undef NSA_KA
#undef NSA_QX
#undef NSA_DMA_K
#undef NSA_DMA_V
#undef NSA_KBASE
        acc_merge(res, a, g2, wsf, r32, hi);
        store_o_lds(res, O, rowb + q0, head * 64, (LAS unsigned short*)park, lane, r32, hi);
    }
}
#undef WAIT_BAR
#undef LGKM0
}

constexpr size_t MiB = 1u << 20;
constexpr size_t WS_SSP = 1 * MiB;
constexpr size_t WS_GATE = 3 * MiB;
constexpr size_t WS_LF = 9 * MiB;
constexpr size_t WS_CUM = 11 * MiB;
constexpr size_t WS_KC = 13 * MiB;
constexpr size_t WS_VC = 14 * MiB;
constexpr size_t WS_MASK = 15 * MiB;
constexpr size_t WS_WIN = 16 * MiB;
constexpr size_t WS_WFOX = 22 * MiB;
constexpr size_t WS_WO0 = 29 * MiB, WS_WO1 = 31 * MiB;
constexpr size_t WS_W1_0 = 33 * MiB, WS_W1_1 = 41 * MiB;
constexpr size_t WS_W2_0 = 49 * MiB, WS_W2_1 = 57 * MiB;
constexpr size_t WS_TBL = 15 * MiB + 512 * 1024;
constexpr size_t WS_WK1 = 65 * MiB;
constexpr size_t WS_XB = 66 * MiB;
constexpr size_t WS_A = 130 * MiB;
constexpr size_t WS_Q = WS_A;
constexpr size_t WS_KV = WS_A + 64 * MiB;
constexpr size_t WS_H = WS_A;
constexpr size_t WS_END = 386 * MiB;

constexpr int NWAVES = 8;
constexpr int LDS_BYTES = 157696;
constexpr int LDS_MISC = 157696 - 64;
constexpr size_t WS_BAR = 0;

#define XB_TMO      128
#define XB_XCNT(j)  (256  + 64 * (j))
#define XB_XSUB(j)  (1280 + 64 * (j))
#define XB_XGEN(j)  (2304 + 64 * (j))
#define XB_TOP      3328
#define XB_TOPGEN   3392
#define XCD_BAR_WORDS 3456
#define XB_SPIN_CAP (1u << 18)

__device__ __forceinline__ unsigned xb_ld(unsigned* p)              { return __hip_atomic_load(p, __ATOMIC_RELAXED, __HIP_MEMORY_SCOPE_AGENT); }
__device__ __forceinline__ unsigned xb_add(unsigned* p, unsigned v) { return __hip_atomic_fetch_add(p, v, __ATOMIC_RELAXED, __HIP_MEMORY_SCOPE_AGENT); }
__device__ __forceinline__ unsigned xb_xcc_id() { return (unsigned)__builtin_amdgcn_s_getreg((3 << 11) | 20) & 0xFu; }
#define XB_SPIN(cond, bar) do { unsigned _sp = 0; while (cond) { __builtin_amdgcn_s_sleep(1); \
    if ((++_sp & 255u) == 0u) { if (xb_ld(&(bar)[XB_TMO])) break; if (_sp > XB_SPIN_CAP) { atomicAdd(&(bar)[XB_TMO], 1u); break; } } } } while (0)

struct XcdBarrier {
    unsigned* bar; unsigned x;
    volatile LAS unsigned* st;
};

__device__ __forceinline__ XcdBarrier xcd_barrier_post(unsigned* bar, volatile LAS unsigned* st) {
    XcdBarrier b; b.bar = bar; b.x = xb_xcc_id(); b.st = st;
    if (threadIdx.x == 0) (void)xb_add(&bar[XB_XCNT(b.x)], 1u);
    return b;
}
__device__ __forceinline__ void xcd_barrier_complete(unsigned* bar, unsigned x, unsigned& nloc, unsigned& nx) {
    const unsigned G = gridDim.x * gridDim.y * gridDim.z;
    unsigned sum, cnt, mine, sp = 0u;
    for (;;) {
        sum = 0u; cnt = 0u; mine = 0u;
#pragma unroll
        for (unsigned j = 0; j < 16; ++j) { const unsigned c = xb_ld(&bar[XB_XCNT(j)]); sum += c; cnt += (c > 0u) ? 1u : 0u; mine = (j == x) ? c : mine; }
        if (sum == G) break;
        __builtin_amdgcn_s_sleep(1);
        if ((++sp & 255u) == 0u) { if (xb_ld(&bar[XB_TMO])) break; if (sp > XB_SPIN_CAP) { atomicAdd(&bar[XB_TMO], 1u); break; } }
    }
    nloc = mine > 0u ? mine : 1u; nx = cnt > 0u ? cnt : 1u;
}

__device__ __forceinline__ void xcd_barrier(const XcdBarrier& b) {
    asm volatile("s_waitcnt vmcnt(0)" ::: "memory");
    __syncthreads();
    if (threadIdx.x == 0) {
        unsigned* bar = b.bar;
        __builtin_amdgcn_s_waitcnt(0);
        unsigned nloc = b.st[0], nx = b.st[1];
        if (nloc == 0u) { xcd_barrier_complete(bar, b.x, nloc, nx); b.st[0] = nloc; b.st[1] = nx; }
        const unsigned old = xb_add(&bar[XB_XSUB(b.x)], 1u);
        const unsigned gen = old / nloc;
        if (old + 1u == (gen + 1u) * nloc) {
            __builtin_amdgcn_fence(__ATOMIC_RELEASE, "agent");
            asm volatile("s_waitcnt vmcnt(0)" ::: "memory");
            const unsigned og = xb_add(&bar[XB_TOP], 1u);
            const unsigned tg = og / nx;
            if (og + 1u == (tg + 1u) * nx) xb_add(&bar[XB_TOPGEN], 1u);
            else XB_SPIN(xb_ld(&bar[XB_TOPGEN]) == tg, bar);
            __builtin_amdgcn_fence(__ATOMIC_ACQUIRE, "agent");
            xb_add(&bar[XB_XGEN(b.x)], 1u);
            asm volatile("s_waitcnt vmcnt(0)" ::: "memory");
        } else {
            XB_SPIN(xb_ld(&bar[XB_XGEN(b.x)]) == gen, bar);
            __builtin_amdgcn_fence(__ATOMIC_ACQUIRE, "agent");
            asm volatile("s_waitcnt vmcnt(0)" ::: "memory");
        }
    }
    __syncthreads();
}

enum Phase { PH_PRO = 0, PH_NSA_IN, PH_CMP, PH_NSA_ATT, PH_NSA_OUT, PH_UP0, PH_DN0, PH_FOX_IN, PH_FOX_ATT, PH_FOX_OUT, PH_UP1, PH_DN1, PH_FINAL, PH_COUNT };
struct Params { const float* in[18]; float* out; unsigned char* ws; int ph_lo, ph_hi; };
enum { I_X = 0, I_RELB, I_NMIX, I_NMLP, I_NSA_WIN, I_PEK, I_WK1, I_WK2, I_PEV, I_WV1, I_WV2, I_NSA_WOUT, I_FOX_WIN, I_FOX_BF, I_FOX_WOUT, I_W1, I_W2, I_FNORM };

__device__ __forceinline__ void phase_prologue(const Params& p, LAS unsigned char* lds, int gw, int NGW, int wave, int lane) {
    LAS float* scr = (LAS float*)(lds + wave * 16384);
    unsigned char* ws = p.ws;
    int base = 0;
#define TMAT(Wp, gainp, K_, N_, NP_, off_) do { const int nblk = (NP_) / 32, nitems = ((K_) / 64) * nblk; \
        int first = gw - (base % NGW); if (first < 0) first += NGW; \
        for (int it = first; it < nitems; it += NGW) transpose_item((Wp), (gainp), (K_), (N_), (bf16*)(ws + (off_)), scr, it, nblk, lane); \
        base += nitems; } while (0)
    TMAT(p.in[I_NSA_WIN], p.in[I_NMIX], D, NSA_IN, NSA_INP, WS_WIN);
    TMAT(p.in[I_FOX_WIN], p.in[I_NMIX] + D, D, FOX_IN, FOX_INP, WS_WFOX);
    TMAT(p.in[I_NSA_WOUT], (const float*)nullptr, D, D, D, WS_WO0);
    TMAT(p.in[I_FOX_WOUT], (const float*)nullptr, D, D, D, WS_WO1);
    TMAT(p.in[I_W1], p.in[I_NMLP], D, DFF, DFF, WS_W1_0);
    TMAT(p.in[I_W1] + (size_t)D * DFF, p.in[I_NMLP] + D, D, DFF, DFF, WS_W1_1);
    TMAT(p.in[I_W2], (const float*)nullptr, DFF, D, D, WS_W2_0);
    TMAT(p.in[I_W2] + (size_t)DFF * D, (const float*)nullptr, DFF, D, D, WS_W2_1);
    TMAT(p.in[I_WK1], (const float*)nullptr, 2048, 64, 64, WS_WK1);
    TMAT(p.in[I_WV1], (const float*)nullptr, 2048, 64, 64, WS_WK1 + 64 * 2048 * 2);
#undef TMAT
    {
        const float* relb = p.in[I_RELB]; float* TBL = (float*)(ws + WS_TBL);
        for (int i = gw * 64 + lane; i < 16 * 704; i += NGW * 64) { const int h = i / 704, dist = i % 704 - 63; float v;
            if (dist < 0) v = -3.0e38f; else if (dist < 128) v = (relb[rel_bucket(dist) * 16 + h] - relb[31 * 16 + h]) * LOG2E; else if (dist < 512) v = 0.f; else v = -3.0e38f;
            TBL[i] = v; }
    }
    const float* x = p.in[I_X]; bf16* XB = (bf16*)(ws + WS_XB); float* SSP = (float*)(ws + WS_SSP);
    for (int m = 4 * gw; m < M; m += 4 * NGW) xrow4_item(x, XB, SSP, m, lane);
}


__global__ void __launch_bounds__(NWAVES * 64, 2) mega(Params p) {
    extern __shared__ __attribute__((aligned(16))) unsigned char lds_raw[];
    LAS unsigned char* lds = (LAS unsigned char*)lds_raw;
    const int tid = threadIdx.x, lane = tid & 63, wave = __builtin_amdgcn_readfirstlane(tid >> 6);
    const int Gd = gridDim.x, gw = blockIdx.x * NWAVES + wave, NGW = Gd * NWAVES;
    unsigned char* ws = p.ws;
    const int lo = p.ph_lo, hi = p.ph_hi;
    cg::grid_group grid = cg::this_grid();
    volatile LAS unsigned* MISC = (volatile LAS unsigned*)(lds + LDS_MISC);
    if (tid < 16) MISC[tid] = 0u;
    __syncthreads();
    XcdBarrier xbar = xcd_barrier_post((unsigned*)(ws + WS_BAR), MISC);
#define IN(k) (lo <= (k) && (k) < hi)
#define SEAM(k) do { if (IN(k) && IN((k) + 1)) xcd_barrier(xbar); } while (0)
    if (hi < 0) grid.sync();
    bf16* XB = (bf16*)(ws + WS_XB); float* SSP = (float*)(ws + WS_SSP);
    if (IN(PH_PRO)) { phase_prologue(p, lds, gw, NGW, wave, lane); }
    SEAM(PH_PRO);
    if (IN(PH_NSA_IN)) {
        pg8::Gemm g{XB, (const bf16*)(ws + WS_WIN), M, 2560, D}; pg8::StaticOrder So; So.init(M, 2560, Gd, (int)blockIdx.x);
        LAS float* rsl = (LAS float*)(lds + pg8::STAGE_BYTES); rstd_prepare(rsl, SSP, So);
        EpiNsaIn E{(bf16*)(ws + WS_Q), (bf16*)(ws + WS_KV), (float*)(ws + WS_GATE), rsl, 0};
        pg8::gemm_phase<EpiNsaIn, pg8::StaticOrder, true, true>(lds, g, So, E);
        skinny_cols<0>(XB, (const bf16*)(ws + WS_WIN) + (size_t)2560 * D, SSP, nullptr, (float*)(ws + WS_GATE), wave * Gd + (int)blockIdx.x, NGW, lane);
    }
    SEAM(PH_NSA_IN);
    if (IN(PH_CMP)) { att::compress_phase(lds, (const bf16*)(ws + WS_KV), p.in[I_PEK], p.in[I_PEV], (const bf16*)(ws + WS_WK1), p.in[I_WK2], p.in[I_WV2], (bf16*)(ws + WS_KC), (bf16*)(ws + WS_VC)); }
    SEAM(PH_CMP);
    if (IN(PH_NSA_ATT)) { att::nsa_phase4(lds, (const bf16*)(ws + WS_Q), (const bf16*)(ws + WS_KV), (const bf16*)(ws + WS_KC), (const bf16*)(ws + WS_VC), (const float*)(ws + WS_GATE), (const float*)(ws + WS_TBL), (bf16*)(ws + WS_Q)); }
    SEAM(PH_NSA_ATT);
    if (IN(PH_NSA_OUT)) {
        pg8::Gemm g{(const bf16*)(ws + WS_Q), (const bf16*)(ws + WS_WO0), M, D, D}; pg8::StaticOrder So; So.init(M, D, Gd, (int)blockIdx.x);
        EpiResid<true> E{p.in[I_X], XB, SSP};
        pg8::gemm_phase<EpiResid<true>, pg8::StaticOrder, true, true>(lds, g, So, E);
    }
    SEAM(PH_NSA_OUT);
    if (IN(PH_UP0)) {
        {   pg8::Gemm g{XB + (size_t)0 * (M / 2) * D, (const bf16*)(ws + WS_W1_0), M / 2, DFF, D}; pg8::StaticOrder So; So.init(M / 2, DFF, Gd, (int)blockIdx.x);
            LAS float* rsl = (LAS float*)(lds + pg8::STAGE_BYTES); rstd_prepare(rsl, SSP + (size_t)0 * (M / 2) * 16, So);
            EpiRelu2 E{(bf16*)(ws + WS_H), rsl, 0};
            pg8::gemm_phase<EpiRelu2, pg8::StaticOrder, true, true>(lds, g, So, E); }
        xcd_barrier(xbar);
        {   pg8::Gemm g{(const bf16*)(ws + WS_H), (const bf16*)(ws + WS_W2_0), M / 2, D, DFF}; pg8::StaticOrder So; So.init(M / 2, D, Gd, (int)blockIdx.x);
            EpiResid<false> E{nullptr, XB + (size_t)0 * (M / 2) * D, SSP + (size_t)0 * (M / 2) * 16};
            pg8::gemm_phase<EpiResid<false>, pg8::StaticOrder, true, true, true>(lds, g, So, E); }
        xcd_barrier(xbar);
        {   pg8::Gemm g{XB + (size_t)1 * (M / 2) * D, (const bf16*)(ws + WS_W1_0), M / 2, DFF, D}; pg8::StaticOrder So; So.init(M / 2, DFF, Gd, (int)blockIdx.x);
            LAS float* rsl = (LAS float*)(lds + pg8::STAGE_BYTES); rstd_prepare(rsl, SSP + (size_t)1 * (M / 2) * 16, So);
            EpiRelu2 E{(bf16*)(ws + WS_H), rsl, 0};
            pg8::gemm_phase<EpiRelu2, pg8::StaticOrder, true, true>(lds, g, So, E); }
        xcd_barrier(xbar);
        {   pg8::Gemm g{(const bf16*)(ws + WS_H), (const bf16*)(ws + WS_W2_0), M / 2, D, DFF}; pg8::StaticOrder So; So.init(M / 2, D, Gd, (int)blockIdx.x);
            EpiResid<false> E{nullptr, XB + (size_t)1 * (M / 2) * D, SSP + (size_t)1 * (M / 2) * 16};
            pg8::gemm_phase<EpiResid<false>, pg8::StaticOrder, true, true, true>(lds, g, So, E); }
    }
    SEAM(PH_DN0);
    if (IN(PH_FOX_IN)) {
        pg8::Gemm g{XB, (const bf16*)(ws + WS_WFOX), M, 3072, D}; pg8::StaticOrder So; So.init(M, 3072, Gd, (int)blockIdx.x);
        LAS float* rsl = (LAS float*)(lds + pg8::STAGE_BYTES); rstd_prepare(rsl, SSP, So);
        EpiFoxIn E{(bf16*)(ws + WS_Q), (bf16*)(ws + WS_KV), (float*)(ws + WS_LF), rsl, p.in[I_FOX_BF], 0};
        pg8::gemm_phase<EpiFoxIn, pg8::StaticOrder, true, true>(lds, g, So, E);
        skinny_cols<1>(XB, (const bf16*)(ws + WS_WFOX) + (size_t)3072 * D, SSP, p.in[I_FOX_BF], (float*)(ws + WS_LF), wave * Gd + (int)blockIdx.x, NGW, lane);
    }
    SEAM(PH_FOX_IN);
    if (IN(PH_FOX_ATT)) { att::fox_phase5(lds, (const bf16*)(ws + WS_Q), (const bf16*)(ws + WS_KV), (const float*)(ws + WS_LF), (bf16*)(ws + WS_Q)); }
    SEAM(PH_FOX_ATT);
    if (IN(PH_FOX_OUT)) {
        pg8::Gemm g{(const bf16*)(ws + WS_Q), (const bf16*)(ws + WS_WO1), M, D, D}; pg8::StaticOrder So; So.init(M, D, Gd, (int)blockIdx.x);
        EpiResid<false> E{nullptr, XB, SSP};
        pg8::gemm_phase<EpiResid<false>, pg8::StaticOrder, true, true>(lds, g, So, E);
    }
    SEAM(PH_FOX_OUT);
    if (IN(PH_UP1)) {
        {   pg8::Gemm g{XB + (size_t)0 * (M / 2) * D, (const bf16*)(ws + WS_W1_1), M / 2, DFF, D}; pg8::StaticOrder So; So.init(M / 2, DFF, Gd, (int)blockIdx.x);
            LAS float* rsl = (LAS float*)(lds + pg8::STAGE_BYTES); rstd_prepare(rsl, SSP + (size_t)0 * (M / 2) * 16, So);
            EpiRelu2 E{(bf16*)(ws + WS_H), rsl, 0};
            pg8::gemm_phase<EpiRelu2, pg8::StaticOrder, true, true>(lds, g, So, E); }
        xcd_barrier(xbar);
        {   pg8::Gemm g{(const bf16*)(ws + WS_H), (const bf16*)(ws + WS_W2_1), M / 2, D, DFF}; pg8::StaticOrder So; So.init(M / 2, D, Gd, (int)blockIdx.x);
            EpiFinal E{XB + (size_t)0 * (M / 2) * D, p.out + (size_t)0 * (M / 2) * D, p.in[I_FNORM], (unsigned*)(ws + WS_CUM) + (size_t)0 * (M / 2) * 4, (unsigned*)(ws + 16384) + 0 * 64 * 64};
            pg8::gemm_phase<EpiFinal, pg8::StaticOrder, false, true, true>(lds, g, So, E); }
        xcd_barrier(xbar);
        {   pg8::Gemm g{XB + (size_t)1 * (M / 2) * D, (const bf16*)(ws + WS_W1_1), M / 2, DFF, D}; pg8::StaticOrder So; So.init(M / 2, DFF, Gd, (int)blockIdx.x);
            LAS float* rsl = (LAS float*)(lds + pg8::STAGE_BYTES); rstd_prepare(rsl, SSP + (size_t)1 * (M / 2) * 16, So);
            EpiRelu2 E{(bf16*)(ws + WS_H), rsl, 0};
            pg8::gemm_phase<EpiRelu2, pg8::StaticOrder, true, true>(lds, g, So, E); }
        xcd_barrier(xbar);
        {   pg8::Gemm g{(const bf16*)(ws + WS_H), (const bf16*)(ws + WS_W2_1), M / 2, D, DFF}; pg8::StaticOrder So; So.init(M / 2, D, Gd, (int)blockIdx.x);
            EpiFinal E{XB + (size_t)1 * (M / 2) * D, p.out + (size_t)1 * (M / 2) * D, p.in[I_FNORM], (unsigned*)(ws + WS_CUM) + (size_t)1 * (M / 2) * 4, (unsigned*)(ws + 16384) + 1 * 64 * 64};
            pg8::gemm_phase<EpiFinal, pg8::StaticOrder, false, true, true>(lds, g, So, E); }
    }
#undef IN
#undef SEAM
}

extern "C" void kernel_launch(void* const* d_in, const int* in_sizes, int n_in, void* d_out, int out_size, void* d_ws, size_t ws_size, hipStream_t stream) {
    static int grid = 0;
    if (grid == 0) {
        if (n_in != 18 || ws_size < WS_END) { fprintf(stderr, "kernel_launch: unexpected inputs / workspace\n"); grid = -1; return; }
        int dev = 0, cus = 0, per_cu = 0;
        (void)hipGetDevice(&dev); (void)hipDeviceGetAttribute(&cus, hipDeviceAttributeMultiprocessorCount, dev);
        (void)hipFuncSetAttribute((const void*)mega, hipFuncAttributeMaxDynamicSharedMemorySize, LDS_BYTES);
        (void)hipOccupancyMaxActiveBlocksPerMultiprocessor(&per_cu, (const void*)mega, NWAVES * 64, LDS_BYTES);
        if (per_cu < 1) { fprintf(stderr, "kernel_launch: occupancy query reports %d blocks per CU\n", per_cu); grid = -1; return; }
        grid = cus;
    }
    if (grid < 0) return;
    Params p{};
    for (int i = 0; i < 18; ++i) p.in[i] = (const float*)d_in[i];
    p.out = (float*)d_out; p.ws = (unsigned char*)d_ws; p.ph_lo = 0; p.ph_hi = PH_COUNT;
    (void)hipMemsetAsync((char*)d_ws + WS_BAR, 0, 65536, stream);
    void* args[] = {&p};
    hipError_t e = hipLaunchCooperativeKernel((const void*)mega, dim3(grid), dim3(NWAVES * 64), args, LDS_BYTES, stream);
    if (e != hipSuccess) fprintf(stderr, "cooperative launch failed: %s (grid %d)\n", hipGetErrorString(e), grid);
}
```

```cpp
#include <hip/hip_runtime.h>
#include <hip/hip_cooperative_groups.h>
#include <cstdint>
#include <cstdio>
namespace cg = cooperative_groups;

constexpr int D = 1024, NB = 16, S = 2048, NH = 16, DH = 64, G = 4, M = NB * S;
constexpr int NSA_IN = 2608, NSA_INP = 2816, FOX_IN = 3088, FOX_INP = 3328, DFF = 4096, NC = 127;
constexpr int KVW = 1536;
constexpr int FKVW = 2048;
constexpr float LOG2E = 1.4426950408889634f;
constexpr float C2 = 0.125f * LOG2E;
constexpr float RMS_EPS = 1e-6f;

namespace pg8 {
#define PG8_LAS __attribute__((address_space(3)))
typedef unsigned short bf16_t;
typedef short bf16x8 __attribute__((ext_vector_type(8)));
typedef float f32x4 __attribute__((ext_vector_type(4)));
typedef unsigned u32x4 __attribute__((ext_vector_type(4)));
typedef unsigned u32x2 __attribute__((ext_vector_type(2)));
constexpr int BM = 256, BK = 64, HALF = 128, HTB = HALF * BK * 2  , STAGE_BYTES = 8 * HTB, NXCD = 8, WGM = 8;

__host__ __device__ __forceinline__ int lds_byte(int r, int c) { const int st = (r >> 4) * 2 + (c >> 5), rr = r & 15, cc = c & 31, ob = rr * 64 + cc * 2; return st * 1024 + (ob ^ (((ob >> 9) & 1) << 5)); }
__host__ __device__ __forceinline__ void stage_rc(int b, int& R, int& C) { const int st = b / 1024, sb = b % 1024, swz = sb ^ (((sb >> 9) & 1) << 5); R = (st >> 1) * 16 + swz / 64; C = (st & 1) * 32 + (swz % 64) / 2; }
__host__ __device__ __forceinline__ int perm32(int rho) { const int n = rho >> 4, i = rho & 15; return 8 * (i >> 2) + 4 * n + (i & 3); }

struct Unit { int pm, pn; };
struct Gemm { const bf16_t* A; const bf16_t* Bt; int M, N, K; };

struct StaticOrder {
    int nM, nN, nwg, G, c;
    __host__ __device__ void init(int M, int N, int G_, int c_) { nM = M / BM; nN = N / BM; nwg = nM * nN; G = G_; c = c_; }
    __host__ __device__ bool next(int i, Unit& u) const {
        const long L = (long)i * G + c; if (L >= nwg) return false;
        int wgid = (int)L; { const int q = nwg / NXCD, r = nwg % NXCD, xcd = wgid % NXCD, off = wgid / NXCD; wgid = (xcd < r ? xcd * (q + 1) : r * (q + 1) + (xcd - r) * q) + off; }
        const int nig = WGM * nN, gid = wgid / nig, fm = gid * WGM, gsz = (nM - fm) < WGM ? (nM - fm) : WGM;
        u.pm = fm + ((wgid % nig) % gsz); u.pn = (wgid % nig) / gsz; return true;
    }
    __device__ __forceinline__ void a_ready(const Unit&) const {}
    __device__ __forceinline__ void done(const Unit&) const {}
};
__device__ __forceinline__ unsigned cvt_pk_bf16(float lo, float hi) { unsigned r; asm volatile("v_cvt_pk_bf16_f32 %0, %1, %2" : "=v"(r) : "v"(lo), "v"(hi)); return r; }
template <class Epi, class Sched, bool ALIGN_EPI = false, bool SP2 = false>
__device__ __forceinline__ void gemm_phase(PG8_LAS unsigned char* lds, const Gemm g, const Sched& S, const Epi& E) {
    const int tid = threadIdx.x, wid = __builtin_amdgcn_readfirstlane(tid >> 6), lane = tid & 63, wr = wid >> 2, wc = wid & 3, fr = lane & 15, fq = lane >> 4;
    const int K = g.K, nt = K / BK;
    unsigned voffA[2], voffB[2];
#pragma unroll
    for (int i = 0; i < 2; ++i) { int R, C; stage_rc(tid * 16 + i * 8192, R, C); const int Rb = Epi::PERM ? ((R & ~31) + perm32(R & 31)) : R;
        voffA[i] = (unsigned)(R * K + C) * 2u; voffB[i] = (unsigned)(Rb * K + C) * 2u; }
    const size_t kstep = (size_t)(BK * 2);
    const size_t hstep = (size_t)HALF * K * 2;
    const size_t tstep = 2 * hstep;
    const unsigned ldsw = (unsigned)wid * 1024u;
    const int aoff = lds_byte(wr * 64 + fr, fq * 8), boff = lds_byte(wc * 32 + fr, fq * 8);
#define PG8_SA(b, h) (((b) * 2 + (h)) * HTB)
#define PG8_SB(b, h) ((4 + (b) * 2 + (h)) * HTB)
#define PG8_STAGE(bufoff, gbase, voff) do { _Pragma("unroll") for (int _i = 0; _i < 2; ++_i) \
        __builtin_amdgcn_global_load_lds((const unsigned*)((const char*)(gbase) + (voff)[_i]), (PG8_LAS unsigned*)(lds + (bufoff) + ldsw + _i * 8192), 16, 0, 0); } while (0)
#define PG8_LDA(dst, b, h) do { _Pragma("unroll") for (int m = 0; m < 4; ++m) _Pragma("unroll") for (int k = 0; k < 2; ++k) dst[m][k] = *(const PG8_LAS bf16x8*)(lds + PG8_SA(b, h) + aoff + m * 2048 + k * 1024); } while (0)
#define PG8_LDB(dst, b, h) do { _Pragma("unroll") for (int n = 0; n < 2; ++n) _Pragma("unroll") for (int k = 0; k < 2; ++k) dst[n][k] = *(const PG8_LAS bf16x8*)(lds + PG8_SB(b, h) + boff + n * 2048 + k * 1024); } while (0)
#define PG8_MMA(ai, bj, At, Bt) do { __builtin_amdgcn_s_setprio(1); _Pragma("unroll") for (int m = 0; m < 4; ++m) _Pragma("unroll") for (int n = 0; n < 2; ++n) _Pragma("unroll") for (int k = 0; k < 2; ++k) \
        acc[ai][bj][m][n] = __builtin_amdgcn_mfma_f32_16x16x32_bf16(Bt[n][k], At[m][k], acc[ai][bj][m][n], 0, 0, 0); __builtin_amdgcn_s_setprio(0); } while (0)
#define PG8_WAIT_V(n) asm volatile("s_waitcnt vmcnt(" #n ")" ::: "memory")
#define PG8_WAIT_L(n) asm volatile("s_waitcnt lgkmcnt(" #n ")" ::: "memory")
#define PG8_BAR __builtin_amdgcn_s_barrier()
#define PG8_SCHED __builtin_amdgcn_sched_barrier(0)
    Unit cur, nxt; int ui = 0;
    if (!S.next(0, cur)) return;
    f32x4 acc[2][2][4][2];
#pragma unroll
    for (int a = 0; a < 2; ++a)
#pragma unroll
        for (int b = 0; b < 2; ++b)
#pragma unroll
            for (int m = 0; m < 4; ++m)
#pragma unroll
                for (int n = 0; n < 2; ++n) acc[a][b][m][n] = (f32x4){0.f, 0.f, 0.f, 0.f};
    bf16x8 At[4][2], B0[2][2], B1[2][2];
    const char* cA = (const char*)g.A + (size_t)cur.pm * tstep; const char* cB = (const char*)g.Bt + (size_t)cur.pn * tstep;
    S.a_ready(cur);
    if constexpr (SP2) {
        PG8_STAGE(PG8_SB(0, 0), cB, voffB); PG8_STAGE(PG8_SB(0, 1), cB + hstep, voffB); PG8_STAGE(PG8_SA(0, 0), cA, voffA); PG8_STAGE(PG8_SA(0, 1), cA + hstep, voffA);
        if (wr == 1) PG8_BAR;
        PG8_WAIT_V(2); PG8_BAR;
        PG8_STAGE(PG8_SB(1, 0), cB + kstep, voffB); PG8_STAGE(PG8_SA(1, 0), cA + kstep, voffA); PG8_STAGE(PG8_SB(1, 1), cB + hstep + kstep, voffB);
        PG8_WAIT_V(6); PG8_BAR;
    } else {
        PG8_STAGE(PG8_SB(0, 0), cB, voffB); PG8_STAGE(PG8_SA(0, 0), cA, voffA); PG8_STAGE(PG8_SB(0, 1), cB + hstep, voffB); PG8_STAGE(PG8_SA(0, 1), cA + hstep, voffA);
        if (wr == 1) PG8_BAR;
        PG8_WAIT_V(4); PG8_BAR;
        PG8_STAGE(PG8_SB(1, 0), cB + kstep, voffB); PG8_STAGE(PG8_SA(1, 0), cA + kstep, voffA); PG8_STAGE(PG8_SB(1, 1), cB + hstep + kstep, voffB);
        PG8_WAIT_V(6); PG8_BAR;
    }
    for (;;) {
        const bool has_next = S.next(ui + 1, nxt);
        const char* nA = has_next ? (const char*)g.A + (size_t)nxt.pm * tstep : cA; const char* nB = has_next ? (const char*)g.Bt + (size_t)nxt.pn * tstep : cB;
        for (int t = 0; t < nt; t += 2) {
            const bool last = (t == nt - 2);
            const char* a1 = cA + (size_t)(t + 1) * kstep;
            const char* a2 = last ? nA : cA + (size_t)(t + 2) * kstep; const char* b2 = last ? nB : cB + (size_t)(t + 2) * kstep;
            const char* a3 = a2 + kstep; const char* b3 = b2 + kstep;
            if (last && has_next) S.a_ready(nxt);
            if constexpr (SP2) {
            PG8_LDB(B0, 0, 0); PG8_LDB(B1, 0, 1); PG8_SCHED; PG8_LDA(At, 0, 0); PG8_STAGE(PG8_SA(1, 1), a1 + hstep, voffA);
            PG8_WAIT_V(8); PG8_WAIT_L(0); PG8_BAR; PG8_MMA(0, 0, At, B0); PG8_MMA(0, 1, At, B1); PG8_BAR; PG8_SCHED;
            PG8_LDA(At, 0, 1); PG8_STAGE(PG8_SB(0, 0), b2, voffB); PG8_STAGE(PG8_SB(0, 1), b2 + hstep, voffB); PG8_STAGE(PG8_SA(0, 0), a2, voffA);
            PG8_WAIT_V(8); PG8_WAIT_L(0); PG8_BAR; PG8_MMA(1, 0, At, B0); PG8_MMA(1, 1, At, B1); PG8_BAR; PG8_SCHED;
            PG8_LDB(B0, 1, 0); PG8_LDB(B1, 1, 1); PG8_SCHED; PG8_LDA(At, 1, 0); PG8_STAGE(PG8_SA(0, 1), a2 + hstep, voffA);
            PG8_WAIT_V(8); PG8_WAIT_L(0); PG8_BAR; PG8_MMA(0, 0, At, B0); PG8_MMA(0, 1, At, B1); PG8_BAR; PG8_SCHED;
            PG8_LDA(At, 1, 1); PG8_STAGE(PG8_SB(1, 0), b3, voffB); PG8_STAGE(PG8_SB(1, 1), b3 + hstep, voffB); PG8_STAGE(PG8_SA(1, 0), a3, voffA);
            PG8_WAIT_V(8); PG8_WAIT_L(0); PG8_BAR; PG8_MMA(1, 0, At, B0); PG8_MMA(1, 1, At, B1); PG8_BAR; PG8_SCHED;
            } else {
            PG8_LDB(B0, 0, 0); PG8_SCHED; PG8_LDA(At, 0, 0); PG8_STAGE(PG8_SA(1, 1), a1 + hstep, voffA);
            PG8_WAIT_L(8); PG8_BAR; PG8_WAIT_L(0); PG8_MMA(0, 0, At, B0); PG8_BAR; PG8_SCHED;
            PG8_LDB(B1, 0, 1); PG8_STAGE(PG8_SB(0, 0), b2, voffB);
            PG8_BAR; PG8_WAIT_L(0); PG8_MMA(0, 1, At, B1); PG8_BAR;
            PG8_LDA(At, 0, 1); PG8_STAGE(PG8_SA(0, 0), a2, voffA);
            PG8_BAR; PG8_WAIT_L(0); PG8_MMA(1, 0, At, B0); PG8_BAR; PG8_SCHED;
            PG8_STAGE(PG8_SB(0, 1), b2 + hstep, voffB);
            PG8_WAIT_V(6); PG8_BAR; PG8_MMA(1, 1, At, B1); PG8_BAR;
            PG8_LDB(B0, 1, 0); PG8_SCHED; PG8_LDA(At, 1, 0); PG8_STAGE(PG8_SA(0, 1), a2 + hstep, voffA);
            PG8_WAIT_L(8); PG8_BAR; PG8_WAIT_L(0); PG8_MMA(0, 0, At, B0); PG8_BAR; PG8_SCHED;
            PG8_LDB(B1, 1, 1); PG8_STAGE(PG8_SB(1, 0), b3, voffB);
            PG8_BAR; PG8_WAIT_L(0); PG8_MMA(0, 1, At, B1); PG8_BAR;
            PG8_LDA(At, 1, 1); PG8_STAGE(PG8_SA(1, 0), a3, voffA);
            PG8_BAR; PG8_WAIT_L(0); PG8_MMA(1, 0, At, B0); PG8_BAR; PG8_SCHED;
            PG8_STAGE(PG8_SB(1, 1), b3 + hstep, voffB);
            PG8_WAIT_V(6); PG8_BAR; PG8_MMA(1, 1, At, B1); PG8_BAR;
            }
        }
        if constexpr (ALIGN_EPI) { if (wr == 0) PG8_BAR; }
        if constexpr (!Epi::AFTER_DRAIN) { E(acc, cur, wr, wc, fr, fq); S.done(cur); }
        if (!has_next) break;
#pragma unroll
        for (int a = 0; a < 2; ++a)
#pragma unroll
            for (int b = 0; b < 2; ++b)
#pragma unroll
                for (int m = 0; m < 4; ++m)
#pragma unroll
                    for (int n = 0; n < 2; ++n) acc[a][b][m][n] = (f32x4){0.f, 0.f, 0.f, 0.f};
        cur = nxt; cA = nA; cB = nB; ++ui;
        if constexpr (ALIGN_EPI) { if (wr == 1) PG8_BAR; }
    }
    PG8_WAIT_V(0);
    if constexpr (!ALIGN_EPI) { if (wr == 0) PG8_BAR; }
    PG8_BAR;
    if constexpr (Epi::AFTER_DRAIN) { E.fused(acc, cur, wr, wc, fr, fq, lds, wid, lane); S.done(cur); }
#undef PG8_SA
#undef PG8_SB
#undef PG8_STAGE
#undef PG8_LDA
#undef PG8_LDB
#undef PG8_MMA
#undef PG8_WAIT_V
#undef PG8_WAIT_L
#undef PG8_BAR
#undef PG8_SCHED
}
}

typedef unsigned short bf16;
typedef float f32x4 __attribute__((ext_vector_type(4)));
typedef unsigned u32x4 __attribute__((ext_vector_type(4)));
typedef unsigned u32x2 __attribute__((ext_vector_type(2)));
#define LAS __attribute__((address_space(3)))
__device__ __forceinline__ float bf2f(unsigned short v) { return __uint_as_float((unsigned)v << 16); }
__device__ __forceinline__ unsigned f2bf(float f) { unsigned u = __float_as_uint(f); return (u + 0x7fffu + ((u >> 16) & 1u)) >> 16; }
__device__ __forceinline__ unsigned pk2(float lo, float hi) { return f2bf(lo) | (f2bf(hi) << 16); }
__device__ __forceinline__ float wave_sum(float v) {
#pragma unroll
    for (int o = 1; o < 64; o <<= 1) v += __shfl_xor(v, o);
    return v;
}
__device__ __forceinline__ int rel_bucket(int dist) {
    int n = dist < 0 ? 0 : dist;
    if (n < 16) return n;
    int large = 16 + (int)(logf((float)n / 16.0f) / logf(8.0f) * 16.0f);
    return large > 31 ? 31 : large;
}

__device__ __forceinline__ u32x4 pack8(const f32x4 v0, const f32x4 v1) { u32x4 w; w.x = pg8::cvt_pk_bf16(v0[0], v0[1]); w.y = pg8::cvt_pk_bf16(v0[2], v0[3]); w.z = pg8::cvt_pk_bf16(v1[0], v1[1]); w.w = pg8::cvt_pk_bf16(v1[2], v1[3]); return w; }

struct EpiNsaIn {
    static constexpr bool PERM = true, AFTER_DRAIN = false;
    bf16* Q; bf16* KV; float* GATE; LAS const float* rsl; mutable int ui;
    __device__ __forceinline__ void operator()(const f32x4 (&acc)[2][2][4][2], const pg8::Unit& u, int wr, int wc, int fr, int fq) const {
        const int row0 = u.pm * 256 + wr * 64 + fr, colt = u.pn * 256 + wc * 32 + 8 * fq;
#pragma unroll
        for (int ai = 0; ai < 2; ++ai)
#pragma unroll
            for (int m = 0; m < 4; ++m) { const int row = row0 + ai * 128 + m * 16; const float rs = rsl[ui * 256 + wr * 64 + fr + ai * 128 + m * 16];
#pragma unroll
                for (int bj = 0; bj < 2; ++bj) { const int col = colt + bj * 128;
                    f32x4 v0 = acc[ai][bj][m][0] * rs, v1 = acc[ai][bj][m][1] * rs;
                    if (col < 1024) { v0 = v0 * C2; v1 = v1 * C2; *(u32x4*)(Q + (size_t)row * D + col) = pack8(v0, v1); }
                    else { *(u32x4*)(KV + (size_t)row * KVW + (col - 1024)) = pack8(v0, v1); }
                } }
        ++ui;
    }
};
struct EpiFoxIn {
    static constexpr bool PERM = true, AFTER_DRAIN = false;
    bf16* Q; bf16* KV; float* LF; LAS const float* rsl; const float* b_f; mutable int ui;
    __device__ __forceinline__ void operator()(const f32x4 (&acc)[2][2][4][2], const pg8::Unit& u, int wr, int wc, int fr, int fq) const {
        const int row0 = u.pm * 256 + wr * 64 + fr, colt = u.pn * 256 + wc * 32 + 8 * fq;
#pragma unroll
        for (int ai = 0; ai < 2; ++ai)
#pragma unroll
            for (int m = 0; m < 4; ++m) { const int row = row0 + ai * 128 + m * 16; const float rs = rsl[ui * 256 + wr * 64 + fr + ai * 128 + m * 16];
#pragma unroll
                for (int bj = 0; bj < 2; ++bj) { const int col = colt + bj * 128;
                    f32x4 v0 = acc[ai][bj][m][0] * rs, v1 = acc[ai][bj][m][1] * rs;
                    if (col < 1024) { v0 = v0 * C2; v1 = v1 * C2; *(u32x4*)(Q + (size_t)row * D + col) = pack8(v0, v1); }
                    else { *(u32x4*)(KV + (size_t)row * FKVW + (col - 1024)) = pack8(v0, v1); }
                } }
        ++ui;
    }
};
struct EpiRelu2 {
    static constexpr bool PERM = true, AFTER_DRAIN = false;
    bf16* Hh; LAS const float* rsl; mutable int ui;
    __device__ __forceinline__ void operator()(const f32x4 (&acc)[2][2][4][2], const pg8::Unit& u, int wr, int wc, int fr, int fq) const {
        const int row0 = u.pm * 256 + wr * 64 + fr, colt = u.pn * 256 + wc * 32 + 8 * fq;
#pragma unroll
        for (int ai = 0; ai < 2; ++ai)
#pragma unroll
            for (int m = 0; m < 4; ++m) { const int row = row0 + ai * 128 + m * 16; const float rs = rsl[ui * 256 + wr * 64 + fr + ai * 128 + m * 16];
#pragma unroll
                for (int bj = 0; bj < 2; ++bj) { const int col = colt + bj * 128;
                    f32x4 v0 = acc[ai][bj][m][0] * rs, v1 = acc[ai][bj][m][1] * rs;
#pragma unroll
                    for (int e = 0; e < 4; ++e) { const float a = fmaxf(v0[e], 0.f), b = fmaxf(v1[e], 0.f); v0[e] = a * a; v1[e] = b * b; }
                    *(u32x4*)(Hh + (size_t)row * DFF + col) = pack8(v0, v1); } }
        ++ui;
    }
};
template <bool IN_F32> struct EpiResid {
    static constexpr bool PERM = true, AFTER_DRAIN = false;
    const float* Xin; bf16* XB; float* SSP;
    __device__ __forceinline__ void operator()(const f32x4 (&acc)[2][2][4][2], const pg8::Unit& u, int wr, int wc, int fr, int fq) const {
        const int row0 = u.pm * 256 + wr * 64 + fr, colt = u.pn * 256 + wc * 32 + 8 * fq;
#pragma unroll
        for (int ai = 0; ai < 2; ++ai)
#pragma unroll
            for (int m = 0; m < 4; ++m) { const int row = row0 + ai * 128 + m * 16; float ssq = 0.f;
#pragma unroll
                for (int bj = 0; bj < 2; ++bj) { const size_t off = (size_t)row * D + colt + bj * 128;
                    f32x4 x0, x1;
                    if (IN_F32) { x0 = *(const f32x4*)(Xin + off); x1 = *(const f32x4*)(Xin + off + 4); }
                    else { const u32x4 r4 = *(const u32x4*)(XB + off);
                        x0[0] = __uint_as_float(r4.x << 16); x0[1] = __uint_as_float(r4.x & 0xffff0000u); x0[2] = __uint_as_float(r4.y << 16); x0[3] = __uint_as_float(r4.y & 0xffff0000u);
                        x1[0] = __uint_as_float(r4.z << 16); x1[1] = __uint_as_float(r4.z & 0xffff0000u); x1[2] = __uint_as_float(r4.w << 16); x1[3] = __uint_as_float(r4.w & 0xffff0000u); }
                    x0 = x0 + acc[ai][bj][m][0]; x1 = x1 + acc[ai][bj][m][1];
                    *(u32x4*)(XB + off) = pack8(x0, x1);
                    ssq += ((x0[0] * x0[0] + x0[1] * x0[1]) + (x0[2] * x0[2] + x0[3] * x0[3])) + ((x1[0] * x1[0] + x1[1] * x1[1]) + (x1[2] * x1[2] + x1[3] * x1[3])); }
                ssq += __shfl_xor(ssq, 16); ssq += __shfl_xor(ssq, 32);
                if (fq == 0) SSP[(size_t)row * 16 + u.pn * 4 + wc] = ssq; }
    }
};

template <bool FRAG = false>
__device__ __forceinline__ void transpose_item(const float* W, const float* gain, int K, int N, bf16* WT, LAS float* scr, int item, int nblk, int lane) {
    const int kb = item / nblk, nb = item % nblk, k0 = 64 * kb, n0 = 32 * nb;
    const int nq = n0 + 4 * (lane & 7);
    f32x4 v[8];
#pragma unroll
    for (int i = 0; i < 8; ++i) { const int kk = 8 * i + (lane >> 3);
        v[i] = (f32x4){0.f, 0.f, 0.f, 0.f};
        if (nq < N) { v[i] = *(const f32x4*)(W + (size_t)(k0 + kk) * N + nq); if (gain) v[i] = v[i] * gain[k0 + kk]; } }
#pragma unroll
    for (int i = 0; i < 8; ++i) { const int kk = 8 * i + (lane >> 3); LAS float* sp = scr + kk * 33 + 4 * (lane & 7);
        sp[0] = v[i][0]; sp[1] = v[i][1]; sp[2] = v[i][2]; sp[3] = v[i][3]; }
    asm volatile("s_waitcnt lgkmcnt(0)" ::: "memory");
    const int c = lane & 7;
#pragma unroll
    for (int j = 0; j < 4; ++j) { const int n = (lane >> 3) + 8 * j; const LAS float* s = scr + (8 * c) * 33 + n;
        u32x4 o; o.x = pk2(s[0 * 33], s[1 * 33]); o.y = pk2(s[2 * 33], s[3 * 33]); o.z = pk2(s[4 * 33], s[5 * 33]); o.w = pk2(s[6 * 33], s[7 * 33]);
        if (FRAG) *(u32x4*)(WT + (size_t)((k0 >> 4) + (c >> 1)) * 1024 + (n0 + n) * 16 + 8 * (c & 1)) = o;
        else *(u32x4*)(WT + (size_t)(n0 + n) * K + k0 + 8 * c) = o; }
    asm volatile("s_waitcnt lgkmcnt(0)" ::: "memory");
}
__device__ __forceinline__ void xrow4_item(const float* x, bf16* XB, float* SSP, int row0, int lane) {
    f32x4 v[4][4]; float s[4];
#pragma unroll
    for (int r = 0; r < 4; ++r) { const f32x4* xr = (const f32x4*)(x + (size_t)(row0 + r) * D) + 2 * lane;
#pragma unroll
        for (int j = 0; j < 2; ++j) { v[r][2 * j] = xr[128 * j]; v[r][2 * j + 1] = xr[128 * j + 1]; } }
#pragma unroll
    for (int r = 0; r < 4; ++r) { float a = 0.f;
#pragma unroll
        for (int j = 0; j < 4; ++j) a += (v[r][j][0] * v[r][j][0] + v[r][j][1] * v[r][j][1]) + (v[r][j][2] * v[r][j][2] + v[r][j][3] * v[r][j][3]);
        s[r] = a; }
#pragma unroll
    for (int o = 1; o < 64; o <<= 1) {
#pragma unroll
        for (int r = 0; r < 4; ++r) s[r] += __shfl_xor(s[r], o); }
#pragma unroll
    for (int r = 0; r < 4; ++r) { u32x4* o16 = (u32x4*)(XB + (size_t)(row0 + r) * D) + lane;
#pragma unroll
        for (int j = 0; j < 2; ++j) { u32x4 w; w.x = pk2(v[r][2 * j][0], v[r][2 * j][1]); w.y = pk2(v[r][2 * j][2], v[r][2 * j][3]); w.z = pk2(v[r][2 * j + 1][0], v[r][2 * j + 1][1]); w.w = pk2(v[r][2 * j + 1][2], v[r][2 * j + 1][3]); o16[64 * j] = w; } }
    const int r = lane >> 4, sl = lane & 15;
    const float sv = (r == 0) ? s[0] : (r == 1) ? s[1] : (r == 2) ? s[2] : s[3];
    SSP[(size_t)(row0 + r) * 16 + sl] = (sl == 0) ? sv : 0.f;
}

template <class Sched> __device__ __forceinline__ void rstd_prepare(LAS float* rsl, const float* SSP, const Sched& So) {
    const int tid = threadIdx.x, r = tid >> 1, half = tid & 1;
    pg8::Unit u;
    for (int i = 0; So.next(i, u); ++i) {
        const f32x4* sp = (const f32x4*)(SSP + (size_t)(u.pm * 256 + r) * 16 + half * 8);
        const f32x4 a = sp[0], c = sp[1];
        float ss = ((a[0] + a[1]) + (a[2] + a[3])) + ((c[0] + c[1]) + (c[2] + c[3]));
        ss += __shfl_xor(ss, 1);
        if (half == 0) rsl[i * 256 + r] = rsqrtf(ss * (1.0f / D) + RMS_EPS);
    }
    __syncthreads();
}

typedef short sk_bf16x8 __attribute__((ext_vector_type(8)));
template <int MODE> __device__ __forceinline__ void skinny_cols(const bf16* XB, const bf16* W, const float* SSP, const float* b_f, float* out, int gw, int NGW, int lane) {
    constexpr int NCB = (MODE == 0) ? 3 : 1, NOUT = (MODE == 0) ? 48 : 16;
    const int r16 = lane & 15, kg = lane >> 4;
    for (int task = gw; task < M / 16; task += NGW) {
        const int row0 = task * 16;
        f32x4 acc[NCB];
#pragma unroll
        for (int cb = 0; cb < NCB; ++cb) acc[cb] = (f32x4){0.f, 0.f, 0.f, 0.f};
        const bf16* ap = XB + (size_t)(row0 + r16) * D + 8 * kg;
        const bf16* bp = W + (size_t)r16 * D + 8 * kg;
#pragma unroll 8
        for (int k0 = 0; k0 < D; k0 += 32) {
            const sk_bf16x8 af = *(const sk_bf16x8*)(ap + k0);
#pragma unroll
            for (int cb = 0; cb < NCB; ++cb) { const sk_bf16x8 bf = *(const sk_bf16x8*)(bp + (size_t)cb * 16 * D + k0);
                acc[cb] = __builtin_amdgcn_mfma_f32_16x16x32_bf16(af, bf, acc[cb], 0, 0, 0); }
        }
        const f32x4* sp = (const f32x4*)(SSP + (size_t)(row0 + r16) * 16);
        const f32x4 sa = sp[0], sb = sp[1], sc = sp[2], sd = sp[3];
        const float ss = (((sa[0] + sa[1]) + (sa[2] + sa[3])) + ((sb[0] + sb[1]) + (sb[2] + sb[3]))) + (((sc[0] + sc[1]) + (sc[2] + sc[3])) + ((sd[0] + sd[1]) + (sd[2] + sd[3])));
        const float rstd = rsqrtf(ss * (1.0f / D) + RMS_EPS);
#pragma unroll
        for (int r = 0; r < 4; ++r) { const int rr = 4 * kg + r; const float rs = __shfl(rstd, rr);
#pragma unroll
            for (int cb = 0; cb < NCB; ++cb) { const int col = cb * 16 + r16; const float v = acc[cb][r] * rs;
                if (MODE == 0) out[(size_t)(row0 + rr) * NOUT + col] = 1.0f / (1.0f + __expf(-v));
                else { const float x = v + b_f[col]; out[(size_t)(row0 + rr) * NOUT + col] = fminf(x, 0.f) - log1pf(__expf(-fabsf(x))); } } }
    }
}

struct EpiFinal {
    static constexpr bool PERM = true, AFTER_DRAIN = true;
    const bf16* XB; float* out; const float* gfin; unsigned* xbuf; unsigned* cnt;
    __device__ __forceinline__ void fused(f32x4 (&acc)[2][2][4][2], const pg8::Unit& u, int wr, int wc, int fr, int fq, PG8_LAS unsigned char* lds, int wid, int lane) const {
        PG8_LAS float* P = (PG8_LAS float*)lds;
        PG8_LAS float* Sr = (PG8_LAS float*)(lds + 4096);
        const int colt = u.pn * 256 + wc * 32 + 8 * fq;
#pragma unroll
        for (int ai = 0; ai < 2; ++ai)
#pragma unroll
            for (int m = 0; m < 4; ++m) { const int rl = ai * 128 + wr * 64 + m * 16 + fr; const size_t rowoff = (size_t)(u.pm * 256 + rl) * D; float ssq = 0.f;
#pragma unroll
                for (int bj = 0; bj < 2; ++bj) { const u32x4 r4 = *(const u32x4*)(XB + rowoff + colt + bj * 128);
                    f32x4 x0 = acc[ai][bj][m][0], x1 = acc[ai][bj][m][1];
                    x0[0] += __uint_as_float(r4.x << 16); x0[1] += __uint_as_float(r4.x & 0xffff0000u); x0[2] += __uint_as_float(r4.y << 16); x0[3] += __uint_as_float(r4.y & 0xffff0000u);
                    x1[0] += __uint_as_float(r4.z << 16); x1[1] += __uint_as_float(r4.z & 0xffff0000u); x1[2] += __uint_as_float(r4.w << 16); x1[3] += __uint_as_float(r4.w & 0xffff0000u);
                    acc[ai][bj][m][0] = x0; acc[ai][bj][m][1] = x1;
                    ssq += ((x0[0] * x0[0] + x0[1] * x0[1]) + (x0[2] * x0[2] + x0[3] * x0[3])) + ((x1[0] * x1[0] + x1[1] * x1[1]) + (x1[2] * x1[2] + x1[3] * x1[3])); }
                ssq += __shfl_xor(ssq, 16); ssq += __shfl_xor(ssq, 32);
                if (fq == 0) P[rl * 4 + wc] = ssq; }
        asm volatile("s_waitcnt lgkmcnt(0)" ::: "memory"); __builtin_amdgcn_s_barrier(); asm volatile("" ::: "memory");
        const int t = wid * 64 + lane;
        if (wid < 4) {
            const f32x4 pv = *(PG8_LAS const f32x4*)(P + t * 4);
            const float tot = (pv[0] + pv[1]) + (pv[2] + pv[3]);
            __hip_atomic_store(xbuf + (size_t)(u.pm * 256 + t) * 4 + u.pn, __float_as_uint(tot), __ATOMIC_RELAXED, __HIP_MEMORY_SCOPE_AGENT);
            asm volatile("s_waitcnt vmcnt(0)" ::: "memory");
            if (lane == 0) __hip_atomic_fetch_add(cnt + 64 * u.pm, 1u, __ATOMIC_RELAXED, __HIP_MEMORY_SCOPE_AGENT);
        }
        if (wid == 0) {
            unsigned sp = 0;
            while ((unsigned)__builtin_amdgcn_readfirstlane(__hip_atomic_load(cnt + 64 * u.pm, __ATOMIC_RELAXED, __HIP_MEMORY_SCOPE_AGENT)) < 16u) { __builtin_amdgcn_s_sleep(2); if (++sp > (1u << 22)) break; }
            __builtin_amdgcn_fence(__ATOMIC_ACQUIRE, "agent");
        }
        asm volatile("s_waitcnt vmcnt(0) lgkmcnt(0)" ::: "memory"); __builtin_amdgcn_s_barrier(); asm volatile("" ::: "memory");
        if (wid < 4) {
            const unsigned* slot = xbuf + (size_t)(u.pm * 256 + t) * 4;
            const float s0 = __uint_as_float(__hip_atomic_load(slot + 0, __ATOMIC_RELAXED, __HIP_MEMORY_SCOPE_AGENT)), s1 = __uint_as_float(__hip_atomic_load(slot + 1, __ATOMIC_RELAXED, __HIP_MEMORY_SCOPE_AGENT));
            const float s2 = __uint_as_float(__hip_atomic_load(slot + 2, __ATOMIC_RELAXED, __HIP_MEMORY_SCOPE_AGENT)), s3 = __uint_as_float(__hip_atomic_load(slot + 3, __ATOMIC_RELAXED, __HIP_MEMORY_SCOPE_AGENT));
            Sr[t] = rsqrtf(((s0 + s1) + (s2 + s3)) * (1.0f / D) + RMS_EPS);
        }
        asm volatile("s_waitcnt lgkmcnt(0)" ::: "memory"); __builtin_amdgcn_s_barrier(); asm volatile("" ::: "memory");
        f32x4 gv[2][2];
#pragma unroll
        for (int bj = 0; bj < 2; ++bj)
#pragma unroll
            for (int n = 0; n < 2; ++n) gv[bj][n] = *(const f32x4*)(gfin + colt + bj * 128 + n * 4);
#pragma unroll
        for (int ai = 0; ai < 2; ++ai)
#pragma unroll
            for (int m = 0; m < 4; ++m) { const int rl = ai * 128 + wr * 64 + m * 16 + fr; const float rs = Sr[rl]; const size_t rowoff = (size_t)(u.pm * 256 + rl) * D;
#pragma unroll
                for (int bj = 0; bj < 2; ++bj)
#pragma unroll
                    for (int n = 0; n < 2; ++n) *(f32x4*)(out + rowoff + colt + bj * 128 + n * 4) = acc[ai][bj][m][n] * rs * gv[bj][n]; }
    }
};

namespace att {
typedef short bf16x8 __attribute__((ext_vector_type(8)));
typedef short s16x4 __attribute__((ext_vector_type(4)));
typedef float f32x16 __attribute__((ext_vector_type(16)));
typedef float f32x2_t __attribute__((ext_vector_type(2)));
typedef __bf16 bf16x2_t __attribute__((ext_vector_type(2)));
typedef short v4i16_t __attribute__((ext_vector_type(4)));
typedef LAS const unsigned char* lptr;
constexpr float NEG = -3.0e38f;
constexpr float THR = 8.0f;
#define WAIT_BAR() asm volatile("s_waitcnt vmcnt(0) lgkmcnt(0)\n\ts_barrier" ::: "memory")
#define LGKM0() asm volatile("s_waitcnt lgkmcnt(0)" ::: "memory")
__device__ __forceinline__ int crow(int r, int hi) { return (r & 3) + 8 * (r >> 2) + 4 * hi; }
__device__ __forceinline__ unsigned cvtpk(float lo, float hi) { f32x2_t v = {lo, hi}; bf16x2_t b = __builtin_convertvector(v, bf16x2_t); return __builtin_bit_cast(unsigned, b); }
__device__ __forceinline__ s16x4 vtr(lptr p) { return __builtin_bit_cast(s16x4, __builtin_amdgcn_ds_read_tr16_b64_v4i16((LAS v4i16_t*)p)); }
__device__ __forceinline__ float xhalf(float v) { const auto rr = __builtin_amdgcn_permlane32_swap(__float_as_uint(v), __float_as_uint(v), false, false); return __uint_as_float((threadIdx.x & 32) ? rr[0] : rr[1]); }

__device__ __forceinline__ void dma_kv(LAS unsigned char* kbuf, LAS unsigned char* vbuf, const bf16* Kg, const bf16* Vg, int pitch, int wave, int lane) {
    __builtin_amdgcn_global_load_lds((const unsigned*)(Kg + (size_t)lane * pitch + wave * 8), (LAS unsigned*)(kbuf + wave * 1024), 16, 0, 0);
    __builtin_amdgcn_global_load_lds((const unsigned*)(Vg + (size_t)(16 * (wave & 3) + (lane >> 2)) * pitch + (wave >> 2) * 32 + (lane & 3) * 8), (LAS unsigned*)(vbuf + wave * 1024), 16, 0, 0);
}
struct Acc { f32x16 o[2]; float m, l; };
__device__ __forceinline__ void acc_init(Acc& a) { a.m = -1.0e30f; a.l = 0.f;
#pragma unroll
    for (int r = 0; r < 16; ++r) { a.o[0][r] = 0.f; a.o[1][r] = 0.f; } }
__device__ __forceinline__ void qk(f32x16& p0, f32x16& p1, lptr kbuf, const bf16x8* qf, int r32, int hi) {
    lptr kb = kbuf + hi * 1024 + r32 * 16;
#pragma unroll
    for (int d0 = 0; d0 < 4; ++d0) {
        const bf16x8 b0 = *(LAS const bf16x8*)(kb + d0 * 2048);
        const bf16x8 b1 = *(LAS const bf16x8*)(kb + d0 * 2048 + 512);
        p0 = __builtin_amdgcn_mfma_f32_32x32x16_bf16(b0, qf[d0], p0, 0, 0, 0);
        p1 = __builtin_amdgcn_mfma_f32_32x32x16_bf16(b1, qf[d0], p1, 0, 0, 0);
    }
}
__device__ __forceinline__ void acc_merge(f32x16 (&res)[2], Acc& a, float gate, LAS float* wsf, int r32, int hi) {
    const float lt = a.l + xhalf(a.l);
    const float f = gate / fmaxf(lt, 1e-30f);
    LGKM0();
    if (hi == 0) wsf[r32] = f;
    LGKM0();
#pragma unroll
    for (int i = 0; i < 4; ++i) { const f32x4 fv = *(LAS const f32x4*)(wsf + 8 * i + 4 * hi);
#pragma unroll
        for (int e = 0; e < 4; ++e) { res[0][4 * i + e] += a.o[0][4 * i + e] * fv[e]; res[1][4 * i + e] += a.o[1][4 * i + e] * fv[e]; } }
    LGKM0();
}


constexpr int TLEN = 704;
__device__ __forceinline__ void gather_c(f32x16& p0, f32x16& p1, LAS const float* Tl) {
#pragma unroll
    for (int r = 0; r < 16; ++r) { const int ko = (r & 3) + 8 * (r >> 2); p0[r] = Tl[63 - ko]; p1[r] = Tl[31 - ko]; }
}
#define OPAQUE(x) asm volatile("" : "+v"(x))

__device__ __forceinline__ float gelu_tanh(float x) { float u = 0.7978845608028654f * (x + 0.044715f * x * x * x); u = fminf(fmaxf(u, -15.0f), 15.0f); const float e = __expf(2.0f * u); return 0.5f * x * (1.0f + (e - 1.0f) / (e + 1.0f)); }
__device__ __forceinline__ void compress_phase(LAS unsigned char* lds, const bf16* KV, const float* pe_k, const float* pe_v, const bf16* W1T, const float* wk2, const float* wv2, bf16* KC, bf16* VC) {
    const int tid = threadIdx.x, lane = tid & 63, wave = __builtin_amdgcn_readfirstlane(tid >> 6), r32 = lane & 31, hi = lane >> 5;
    LAS float* part = (LAS float*)lds;
    LAS float* hid = (LAS float*)(lds + 65536);
    LAS float* w2s = (LAS float*)(lds + 81920);
    LAS float* pes = (LAS float*)(lds + 98304);
    int staged = -1;
    for (int u = blockIdx.x; u < 64 * 2 * 4; u += gridDim.x) {
        const int cblk = u & 3, which = (u >> 2) & 1, bg = u >> 3, b = bg >> 2, g = bg & 3;
        if (which != staged) {
            __syncthreads();
            const float* w2g = which ? wv2 : wk2; const float* peg = which ? pe_v : pe_k;
            *(LAS f32x4*)(w2s + 4 * tid) = *(const f32x4*)(w2g + 4 * tid); *(LAS f32x4*)(w2s + 2048 + 4 * tid) = *(const f32x4*)(w2g + 2048 + 4 * tid);
            *(LAS f32x4*)(pes + 4 * tid) = *(const f32x4*)(peg + 4 * tid);
            __syncthreads(); staged = which;
        }
        const bf16* w1t = W1T + (size_t)which * 64 * 2048;
        bf16* out = which ? VC : KC;
        f32x16 acc0, acc1;
#pragma unroll
        for (int r = 0; r < 16; ++r) { acc0[r] = 0.f; acc1[r] = 0.f; }
        __syncthreads();
        {   const bf16* src = KV + (size_t)b * S * KVW + which * 256 + g * 64;
            u32x4 st[9];
#pragma unroll
            for (int i = 0; i < 9; ++i) { const int q = tid + 512 * i, r = q >> 3, ch = q & 7; int tok = 512 * cblk + r; if (tok > S - 1) tok = S - 1;
                if (q < 528 * 8) st[i] = *(const u32x4*)(src + (size_t)tok * KVW + ch * 8); }
#pragma unroll
            for (int i = 0; i < 9; ++i) { const int q = tid + 512 * i, r = q >> 3, ch = q & 7;
                if (q < 528 * 8) *(LAS u32x4*)(lds + r * 128 + ((ch ^ ((r >> 4) & 7)) * 16)) = st[i]; }
        }
        __syncthreads();
#pragma unroll 1
        for (int h2 = 0; h2 < 2; ++h2) {
            bf16x8 b0[8], b1[8];
#pragma unroll
            for (int q = 0; q < 8; ++q) { const int k0 = 256 * wave + 16 * (8 * h2 + q);
                b0[q] = *(const bf16x8*)(w1t + (size_t)(k0 >> 4) * 1024 + r32 * 16 + 8 * hi);
                b1[q] = *(const bf16x8*)(w1t + (size_t)(k0 >> 4) * 1024 + (r32 + 32) * 16 + 8 * hi); }
#pragma unroll
            for (int q = 0; q < 8; ++q) { const int k0 = 256 * wave + 16 * (8 * h2 + q), l = k0 >> 6, d = (k0 & 63) + 8 * hi, r = 16 * r32 + l;
                const u32x4 raw = *(LAS const u32x4*)(lds + r * 128 + (((d >> 3) ^ ((r >> 4) & 7)) * 16));
                const f32x4 pa_ = *(LAS const f32x4*)(pes + l * 64 + d), pb_ = *(LAS const f32x4*)(pes + l * 64 + d + 4);
                u32x4 w;
                w.x = cvtpk(__uint_as_float(raw.x << 16) + pa_[0], __uint_as_float(raw.x & 0xffff0000u) + pa_[1]);
                w.y = cvtpk(__uint_as_float(raw.y << 16) + pa_[2], __uint_as_float(raw.y & 0xffff0000u) + pa_[3]);
                w.z = cvtpk(__uint_as_float(raw.z << 16) + pb_[0], __uint_as_float(raw.z & 0xffff0000u) + pb_[1]);
                w.w = cvtpk(__uint_as_float(raw.w << 16) + pb_[2], __uint_as_float(raw.w & 0xffff0000u) + pb_[3]);
                const bf16x8 af = __builtin_bit_cast(bf16x8, w);
                acc0 = __builtin_amdgcn_mfma_f32_32x32x16_bf16(af, b0[q], acc0, 0, 0, 0);
                acc1 = __builtin_amdgcn_mfma_f32_32x32x16_bf16(af, b1[q], acc1, 0, 0, 0); }
        }
        __syncthreads();
#pragma unroll
        for (int r = 0; r < 16; ++r) { LAS float* pp = part + wave * 2048 + crow(r, hi) * 64 + r32; pp[0] = acc0[r]; pp[32] = acc1[r]; }
        __syncthreads();
        const int cr = tid >> 4, n4 = (tid & 15) * 4;
        {   f32x4 sum = *(LAS const f32x4*)(part + cr * 64 + n4);
#pragma unroll
            for (int w = 1; w < 8; ++w) sum = sum + *(LAS const f32x4*)(part + w * 2048 + cr * 64 + n4);
            f32x4 hv; hv[0] = gelu_tanh(sum[0]); hv[1] = gelu_tanh(sum[1]); hv[2] = gelu_tanh(sum[2]); hv[3] = gelu_tanh(sum[3]);
            *(LAS f32x4*)(hid + cr * 64 + n4) = hv; }
        __syncthreads();
        f32x4 o = {0.f, 0.f, 0.f, 0.f};
#pragma unroll 8
        for (int i = 0; i < 64; ++i) { const float hvv = hid[cr * 64 + i]; const f32x4 wv = *(LAS const f32x4*)(w2s + i * 64 + n4); o = o + hvv * wv; }
        const int cg_ = cblk * 32 + cr;
        if (cg_ >= NC) o = (f32x4){0.f, 0.f, 0.f, 0.f};
        u32x2 pk; pk.x = cvtpk(o[0], o[1]); pk.y = cvtpk(o[2], o[3]);
        *(u32x2*)(out + ((size_t)bg * 128 + cg_) * 64 + n4) = pk;
    }
}
#undef OPAQUE
#undef WAIT_BAR
#undef LGKM0
}

namespace att {
#define WAIT_BAR() asm volatile("s_waitcnt vmcnt(0) lgkmcnt(0)\n\ts_barrier" ::: "memory")
#define LGKM0() asm volatile("s_waitcnt lgkmcnt(0)" ::: "memory")

#undef WAIT_BAR
#undef LGKM0
}

namespace att {
#define LGKM0() asm volatile("s_waitcnt lgkmcnt(0)" ::: "memory")
template <bool MASKROWS>
__device__ __forceinline__ void exp_pack(float& lsum, f32x16& c0, f32x16& c1, bf16x8 (&pa)[4], bool okc) {
    float s0 = 0.f, s1 = 0.f;
#pragma unroll
    for (int r = 0; r < 16; ++r) { c0[r] = __builtin_amdgcn_exp2f(c0[r]); c1[r] = __builtin_amdgcn_exp2f(c1[r]); s0 += c0[r]; s1 += c1[r]; }
    const unsigned km = (MASKROWS && !okc) ? 0u : 0xffffffffu;
#pragma unroll
    for (int s = 0; s < 2; ++s) {
        u32x4 w0, w1;
        w0.x = cvtpk(c0[8 * s + 0], c0[8 * s + 1]); w0.y = cvtpk(c0[8 * s + 2], c0[8 * s + 3]); w0.z = cvtpk(c0[8 * s + 4], c0[8 * s + 5]); w0.w = cvtpk(c0[8 * s + 6], c0[8 * s + 7]);
        w1.x = cvtpk(c1[8 * s + 0], c1[8 * s + 1]); w1.y = cvtpk(c1[8 * s + 2], c1[8 * s + 3]); w1.z = cvtpk(c1[8 * s + 4], c1[8 * s + 5]); w1.w = cvtpk(c1[8 * s + 6], c1[8 * s + 7]);
        if (MASKROWS) { w0 = w0 & km; w1 = w1 & km; }
        pa[s] = __builtin_bit_cast(bf16x8, w0); pa[2 + s] = __builtin_bit_cast(bf16x8, w1);
    }
    const float st = s0 + s1;
    lsum += (MASKROWS && !okc) ? 0.f : st;
}
__device__ __forceinline__ float qnorm32(const bf16x8* qf) {
    float s = 0.f;
#pragma unroll
    for (int d0 = 0; d0 < 4; ++d0)
#pragma unroll
        for (int j = 0; j < 8; ++j) { const float v = bf2f((unsigned short)qf[d0][j]); s += v * v; }
    s += xhalf(s);
    return sqrtf(s);
}

#undef LGKM0
}

namespace att {
__device__ __forceinline__ void glds16s(unsigned voff, const void* sbase, unsigned lds_dst) { unsigned keep;
    asm volatile("s_mov_b32 %0, m0\n\ts_mov_b32 m0, %3\n\ts_nop 0\n\tglobal_load_lds_dwordx4 %1, %2\n\ts_mov_b32 m0, %0" : "=&s"(keep) : "v"(voff), "s"(sbase), "s"(lds_dst) : "memory"); }
__device__ __forceinline__ const bf16* uni(const bf16* p) {
    const unsigned long long v = (unsigned long long)p;
    const unsigned lo = __builtin_amdgcn_readfirstlane((unsigned)v), hi = __builtin_amdgcn_readfirstlane((unsigned)(v >> 32));
    return (const bf16*)(((unsigned long long)hi << 32) | lo);
}
__device__ __forceinline__ void qk4z(f32x16& p0, f32x16& p1, const unsigned (&ka)[4], const bf16x8* qf) {
    const f32x16 z = {0.f, 0.f, 0.f, 0.f, 0.f, 0.f, 0.f, 0.f, 0.f, 0.f, 0.f, 0.f, 0.f, 0.f, 0.f, 0.f};
    {   const bf16x8 b0 = *(LAS const bf16x8*)(uintptr_t)ka[0], b1 = *(LAS const bf16x8*)(uintptr_t)(ka[0] + 4096);
        p0 = __builtin_amdgcn_mfma_f32_32x32x16_bf16(b0, qf[0], z, 0, 0, 0);
        p1 = __builtin_amdgcn_mfma_f32_32x32x16_bf16(b1, qf[0], z, 0, 0, 0); }
#pragma unroll
    for (int d0 = 1; d0 < 4; ++d0) {
        const bf16x8 b0 = *(LAS const bf16x8*)(uintptr_t)ka[d0], b1 = *(LAS const bf16x8*)(uintptr_t)(ka[d0] + 4096);
        p0 = __builtin_amdgcn_mfma_f32_32x32x16_bf16(b0, qf[d0], p0, 0, 0, 0);
        p1 = __builtin_amdgcn_mfma_f32_32x32x16_bf16(b1, qf[d0], p1, 0, 0, 0);
    }
}
__device__ __forceinline__ void qk4c(f32x16& p0, f32x16& p1, const f32x16& ci0, const f32x16& ci1, const unsigned (&ka)[4], const bf16x8* qf) {
    {   const bf16x8 b0 = *(LAS const bf16x8*)(uintptr_t)ka[0], b1 = *(LAS const bf16x8*)(uintptr_t)(ka[0] + 4096);
        p0 = __builtin_amdgcn_mfma_f32_32x32x16_bf16(b0, qf[0], ci0, 0, 0, 0);
        p1 = __builtin_amdgcn_mfma_f32_32x32x16_bf16(b1, qf[0], ci1, 0, 0, 0); }
#pragma unroll
    for (int d0 = 1; d0 < 4; ++d0) {
        const bf16x8 b0 = *(LAS const bf16x8*)(uintptr_t)ka[d0], b1 = *(LAS const bf16x8*)(uintptr_t)(ka[d0] + 4096);
        p0 = __builtin_amdgcn_mfma_f32_32x32x16_bf16(b0, qf[d0], p0, 0, 0, 0);
        p1 = __builtin_amdgcn_mfma_f32_32x32x16_bf16(b1, qf[d0], p1, 0, 0, 0);
    }
}
__device__ __forceinline__ void pv4(f32x16 (&o)[2], const bf16x8 (&pa)[4], unsigned va) {
#pragma unroll
    for (int d0 = 0; d0 < 2; ++d0)
#pragma unroll
        for (int ks = 0; ks < 4; ++ks) {
            const s16x4 lo = vtr((lptr)(uintptr_t)(va + d0 * 4096 + ks * 1024)), hh = vtr((lptr)(uintptr_t)(va + d0 * 4096 + ks * 1024 + 512));
            const bf16x8 vf = (bf16x8){lo[0], lo[1], lo[2], lo[3], hh[0], hh[1], hh[2], hh[3]};
            o[d0] = __builtin_amdgcn_mfma_f32_32x32x16_bf16(pa[ks], vf, o[d0], 0, 0, 0);
        }
}


__device__ __forceinline__ void store_o_lds(const f32x16 (&res)[2], bf16* O, size_t row0, int col0, LAS unsigned short* stg, int lane, int r32, int hi) {
#pragma unroll
    for (int r = 0; r < 16; ++r) { const int orow = crow(r, hi);
        stg[orow * 64 + r32] = (unsigned short)f2bf(res[0][r]); stg[orow * 64 + 32 + r32] = (unsigned short)f2bf(res[1][r]); }
    asm volatile("s_waitcnt lgkmcnt(0)" ::: "memory");
#pragma unroll
    for (int i = 0; i < 4; ++i) { const int row = i * 8 + (lane >> 3), ch = lane & 7;
        const u32x4 v = *(LAS const u32x4*)(stg + row * 64 + ch * 8);
        *(u32x4*)(O + (row0 + row) * D + col0 + ch * 8) = v; }
    asm volatile("s_waitcnt lgkmcnt(0)" ::: "memory");
}
__device__ __forceinline__ void fox_phase4(LAS unsigned char* lds, const bf16* Q, const bf16* KV, const float* LF, bf16* O) {
    const int tid = threadIdx.x, wave = __builtin_amdgcn_readfirstlane(tid >> 6);
    const unsigned lds0 = (unsigned)(uintptr_t)lds;
    LAS unsigned char* KX = lds + 65536;
    LAS float* nc2 = (LAS float*)(lds + 98304);
    LAS float* wsf = (LAS float*)(lds + 106496) + wave * 64;
    LAS float* wt = (LAS float*)(lds + 108544);
    LAS float* wmx = wt + 16;
    for (int bh = blockIdx.x; bh < NB * NH; bh += gridDim.x) {
        const int b = bh >> 4, h = bh & 15;
        const size_t rowb = (size_t)b * S;
        const bf16* Kg = uni(KV + rowb * FKVW + h * 64); const bf16* Vg = Kg + 1024;
        float kmax;
        {   const int lane = tid & 63;
            float v[4]; float tot = 0.f, kn = 0.f;
#pragma unroll
            for (int i = 0; i < 4; ++i) { tot += LF[(rowb + 4 * tid + i) * 16 + h]; v[i] = tot;
                const u32x4* kr = (const u32x4*)(Kg + (size_t)(4 * tid + i) * FKVW); float s = 0.f;
#pragma unroll
                for (int c = 0; c < 8; ++c) { const u32x4 w = kr[c];
                    const float a0 = __uint_as_float(w.x << 16), a1 = __uint_as_float(w.x & 0xffff0000u), a2 = __uint_as_float(w.y << 16), a3 = __uint_as_float(w.y & 0xffff0000u);
                    const float a4 = __uint_as_float(w.z << 16), a5 = __uint_as_float(w.z & 0xffff0000u), a6 = __uint_as_float(w.w << 16), a7 = __uint_as_float(w.w & 0xffff0000u);
                    s += (a0 * a0 + a1 * a1) + (a2 * a2 + a3 * a3) + (a4 * a4 + a5 * a5) + (a6 * a6 + a7 * a7); }
                kn = fmaxf(kn, s); }
            float inc = tot;
#pragma unroll
            for (int o = 1; o < 64; o <<= 1) { const float n = __shfl_up(inc, o), n2 = __shfl_up(kn, o); if (lane >= o) { inc += n; kn = fmaxf(kn, n2); } }
            __syncthreads();
            if (lane == 63) { wt[wave] = inc; wmx[wave] = kn; }
            __syncthreads();
            float base = inc - tot;
            for (int w = 0; w < wave; ++w) base += wt[w];
            kn = wmx[0];
#pragma unroll
            for (int w = 1; w < 8; ++w) kn = fmaxf(kn, wmx[w]);
            kmax = sqrtf(kn);
#pragma unroll
            for (int i = 0; i < 4; ++i) { const float x = -(base + v[i]) * LOG2E; nc2[4 * tid + i] = x;
                const unsigned hb = f2bf(x); const float r1 = x - __uint_as_float(hb << 16);
                const unsigned lb = f2bf(r1); const float r2 = r1 - __uint_as_float(lb << 16);
                const unsigned llb = f2bf(r2);
                u32x4 e; e.x = hb | (lb << 16); e.y = llb | 0x3f800000u; e.z = 0u; e.w = 0u;
                *(LAS u32x4*)(KX + (size_t)(4 * tid + i) * 16) = e; }
            __syncthreads();
        }
#pragma unroll 1
        for (int qb = 7; qb >= 0; --qb) {
            int lnu_ = tid & 63; asm volatile("" : "+v"(lnu_));
            const int lane = lnu_, r32 = lnu_ & 31, hi = lnu_ >> 5;
            const int q0 = 256 * qb + 32 * wave, qpos = q0 + r32, NT = 4 * qb + 4;
            const int nact = (q0 + 31) / 64 + 1;
            bf16x8 qf[4];
#pragma unroll
            for (int d0 = 0; d0 < 4; ++d0) qf[d0] = *(const bf16x8*)(Q + (rowb + qpos) * D + h * 64 + d0 * 16 + hi * 8);
            const float mrow = qnorm32(qf) * kmax + nc2[qpos];
            const unsigned mbb = f2bf(mrow * 1.01f + 1.0f);
            u32x4 qxw; qxw.x = hi ? 0u : 0x3f803f80u; qxw.y = hi ? 0u : (0x00003f80u | ((mbb ^ 0x8000u) << 16)); qxw.z = 0u; qxw.w = 0u;
            const bf16x8 qx = __builtin_bit_cast(bf16x8, qxw);
            unsigned kofs[4];
#pragma unroll
            for (int d0 = 0; d0 < 4; ++d0) kofs[d0] = lds0 + r32 * 128 + (((2 * d0 + hi) ^ ((r32 >> 1) & 7)) << 4);
            const unsigned vbo = lds0 + 32768 + ((lane >> 4) & 1) * 32 + (lane & 3) * 8 + (4 * hi + ((lane & 15) >> 2)) * 64;
            const unsigned kxo = lds0 + 65536 + r32 * 16;
            const int krow = 8 * wave + (lane >> 3);
            const unsigned kdma = (unsigned)krow * (FKVW * 2) + (((lane & 7) ^ ((krow >> 1) & 7)) << 4);
            const unsigned vdma = (unsigned)(16 * (wave & 3) + (lane >> 2)) * (FKVW * 2) + (wave >> 2) * 64 + (lane & 3) * 16;
            const unsigned kdst = lds0 + wave * 1024, vdst = lds0 + 32768 + wave * 1024;
            Acc a; acc_init(a);
#define FOX_DMA_K(t) glds16s(kdma, Kg + (size_t)(t) * 64 * FKVW, (unsigned)__builtin_amdgcn_readfirstlane(kdst + ((t) & 3) * 8192))
#define FOX_DMA_V(t) glds16s(vdma, Vg + (size_t)(t) * 64 * FKVW, (unsigned)__builtin_amdgcn_readfirstlane(vdst + ((t) & 3) * 8192))
            if (qb == 7) {
                asm volatile("s_waitcnt vmcnt(0) lgkmcnt(0)\n\ts_barrier" ::: "memory");
                FOX_DMA_K(0); FOX_DMA_V(0); FOX_DMA_K(1); FOX_DMA_K(2); FOX_DMA_V(1);
            }
            asm volatile("s_waitcnt vmcnt(0) lgkmcnt(0)\n\ts_barrier" ::: "memory");
#define FOX_BIAS(P0, P1, t) do { const unsigned kxa = kxo + (unsigned)(t) * 1024u; \
                const bf16x8 x0 = *(LAS const bf16x8*)(uintptr_t)kxa, x1 = *(LAS const bf16x8*)(uintptr_t)(kxa + 512); \
                P0 = __builtin_amdgcn_mfma_f32_32x32x16_bf16(x0, qx, P0, 0, 0, 0); P1 = __builtin_amdgcn_mfma_f32_32x32x16_bf16(x1, qx, P1, 0, 0, 0); } while (0)
#define FOX_KA(t) unsigned ka[4]; { const unsigned so = (unsigned)((t) & 3) * 8192u; ka[0] = kofs[0] + so; ka[1] = kofs[1] + so; ka[2] = kofs[2] + so; ka[3] = kofs[3] + so; }
#define FOX_SCORES_Z(P0, P1, t) do { FOX_KA(t) qk4z(P0, P1, ka, qf); FOX_BIAS(P0, P1, t); } while (0)
#define FOX_SCORES_D(P0, P1, t) do { const int k0_ = 64 * (t); f32x16 ci0, ci1; \
                _Pragma("unroll") for (int r = 0; r < 16; ++r) { const int key = k0_ + crow(r, hi); ci0[r] = (key > qpos) ? NEG : 0.f; ci1[r] = (key + 32 > qpos) ? NEG : 0.f; } \
                FOX_KA(t) qk4c(P0, P1, ci0, ci1, ka, qf); FOX_BIAS(P0, P1, t); } while (0)
            f32x16 sA0, sA1, sB0, sB1;
            if (nact == 1) FOX_SCORES_D(sA0, sA1, 0); else FOX_SCORES_Z(sA0, sA1, 0);
#define FOX_PREFIX(j) \
            if ((j) + 2 < NT) asm volatile("s_waitcnt vmcnt(2) lgkmcnt(0)\n\ts_barrier" ::: "memory"); \
            else if ((j) + 1 < NT) asm volatile("s_waitcnt vmcnt(1) lgkmcnt(0)\n\ts_barrier" ::: "memory"); \
            else asm volatile("s_waitcnt vmcnt(0) lgkmcnt(0)\n\ts_barrier" ::: "memory");     \
            if ((j) + 3 < NT) FOX_DMA_K((j) + 3); \
            if ((j) + 2 < NT) FOX_DMA_V((j) + 2);
#define FOX_FULLZ(C0, C1, N0, N1, j) do { FOX_PREFIX(j) bf16x8 pa[4]; \
                FOX_SCORES_Z(N0, N1, (j) + 1);       \
                exp_pack<false>(a.l, C0, C1, pa, true); \
                pv4(a.o, pa, vbo + (unsigned)((j) & 3) * 8192u); } while (0)
#define FOX_FULLD(C0, C1, N0, N1, j) do { FOX_PREFIX(j) bf16x8 pa[4]; \
                FOX_SCORES_D(N0, N1, (j) + 1); \
                exp_pack<false>(a.l, C0, C1, pa, true); \
                pv4(a.o, pa, vbo + (unsigned)((j) & 3) * 8192u); } while (0)
#define FOX_TAIL(C0, C1, j) do { FOX_PREFIX(j) bf16x8 pa[4]; \
                exp_pack<false>(a.l, C0, C1, pa, true); \
                pv4(a.o, pa, vbo + (unsigned)((j) & 3) * 8192u); } while (0)
            int j = 0; const int n1 = nact - 2;
#pragma unroll 1
            for (; j + 1 < n1; j += 2) { FOX_FULLZ(sA0, sA1, sB0, sB1, j); FOX_FULLZ(sB0, sB1, sA0, sA1, j + 1); }
            if (j < n1) { FOX_FULLZ(sA0, sA1, sB0, sB1, j); sA0 = sB0; sA1 = sB1; ++j; }
            if (nact >= 2) { FOX_FULLD(sA0, sA1, sB0, sB1, j); ++j; FOX_TAIL(sB0, sB1, j); ++j; }
            else { FOX_TAIL(sA0, sA1, j); ++j; }
#pragma unroll 1
            for (; j < NT; ++j) { FOX_PREFIX(j) }
            if (qb > 0) { FOX_DMA_K(0); FOX_DMA_V(0); FOX_DMA_K(1); FOX_DMA_K(2); FOX_DMA_V(1); }
#undef FOX_FULLZ
#undef FOX_FULLD
#undef FOX_TAIL
#undef FOX_BIAS
#undef FOX_KA
#undef FOX_SCORES_Z
#undef FOX_SCORES_D
#undef FOX_PREFIX
#undef FOX_DMA_K
#undef FOX_DMA_V
            f32x16 res[2];
#pragma unroll
            for (int r = 0; r < 16; ++r) { res[0][r] = 0.f; res[1][r] = 0.f; }
            acc_merge(res, a, 1.0f, wsf, r32, hi);
            store_o_lds(res, O, rowb + q0, h * 64, (LAS unsigned short*)(lds + 110592) + wave * 2048, lane, r32, hi);
        }
    }
}

__device__ __forceinline__ void fox_phase5(LAS unsigned char* lds, const bf16* Q, const bf16* KV, const float* LF, bf16* O) {
    const int tid = threadIdx.x, wave = __builtin_amdgcn_readfirstlane(tid >> 6);
    const unsigned lds0 = (unsigned)(uintptr_t)lds;
    LAS unsigned char* KX = lds + 65536;
    LAS float* nc2 = (LAS float*)(lds + 98304);
    LAS float* wsf = (LAS float*)(lds + 106496) + wave * 64;
    LAS float* wt = (LAS float*)(lds + 108544);
    LAS float* wmx = wt + 16;
    for (int bh = blockIdx.x; bh < NB * NH; bh += gridDim.x) {
        const int b = bh >> 4, h = bh & 15;
        const size_t rowb = (size_t)b * S;
        const bf16* Kg = uni(KV + rowb * FKVW + h * 64); const bf16* Vg = Kg + 1024;
        float kmax;
        {   int tidl = tid; asm volatile("" : "+v"(tidl));
            const int lane = tidl & 63;
            float v[4]; float tot = 0.f, kn = 0.f;
#pragma unroll
            for (int i = 0; i < 4; ++i) { tot += LF[(rowb + 4 * tidl + i) * 16 + h]; v[i] = tot;
                const u32x4* kr = (const u32x4*)(Kg + (size_t)(4 * tidl + i) * FKVW); float s = 0.f;
#pragma unroll
                for (int c = 0; c < 8; ++c) { const u32x4 w = kr[c];
                    const float a0 = __uint_as_float(w.x << 16), a1 = __uint_as_float(w.x & 0xffff0000u), a2 = __uint_as_float(w.y << 16), a3 = __uint_as_float(w.y & 0xffff0000u);
                    const float a4 = __uint_as_float(w.z << 16), a5 = __uint_as_float(w.z & 0xffff0000u), a6 = __uint_as_float(w.w << 16), a7 = __uint_as_float(w.w & 0xffff0000u);
                    s += (a0 * a0 + a1 * a1) + (a2 * a2 + a3 * a3) + (a4 * a4 + a5 * a5) + (a6 * a6 + a7 * a7); }
                kn = fmaxf(kn, s); }
            float inc = tot;
#pragma unroll
            for (int o = 1; o < 64; o <<= 1) { const float n = __shfl_up(inc, o), n2 = __shfl_up(kn, o); if (lane >= o) { inc += n; kn = fmaxf(kn, n2); } }
            __syncthreads();
            if (lane == 63) { wt[wave] = inc; wmx[wave] = kn; }
            __syncthreads();
            float base = inc - tot;
            for (int w = 0; w < wave; ++w) base += wt[w];
            kn = wmx[0];
#pragma unroll
            for (int w = 1; w < 8; ++w) kn = fmaxf(kn, wmx[w]);
            kmax = sqrtf(kn);
#pragma unroll
            for (int i = 0; i < 4; ++i) { const float x = -(base + v[i]) * LOG2E; nc2[4 * tidl + i] = x;
                const unsigned hb = f2bf(x); const float r1 = x - __uint_as_float(hb << 16);
                const unsigned lb = f2bf(r1); const float r2 = r1 - __uint_as_float(lb << 16);
                const unsigned llb = f2bf(r2);
                u32x4 e; e.x = hb | (lb << 16); e.y = llb | 0x3f800000u; e.z = 0u; e.w = 0u;
                *(LAS u32x4*)(KX + (size_t)(4 * tidl + i) * 16) = e; }
            __syncthreads();
        }
#pragma unroll 1
        for (int qb = 3; qb >= 0; --qb) {
            int lnu_ = tid & 63; asm volatile("" : "+v"(lnu_));
            const int lane = lnu_, r32 = lnu_ & 31, hi = lnu_ >> 5;
            const int q0 = 512 * qb + 64 * wave, qposA = q0 + r32, qposB = qposA + 32, NT = 8 * qb + 8;
            const int nact = 8 * qb + wave + 1;
            bf16x8 qfA[4], qfB[4];
#pragma unroll
            for (int d0 = 0; d0 < 4; ++d0) { qfA[d0] = *(const bf16x8*)(Q + (rowb + qposA) * D + h * 64 + d0 * 16 + hi * 8); qfB[d0] = *(const bf16x8*)(Q + (rowb + qposB) * D + h * 64 + d0 * 16 + hi * 8); }
            const unsigned mbA = f2bf((qnorm32(qfA) * kmax + nc2[qposA]) * 1.01f + 1.0f), mbB = f2bf((qnorm32(qfB) * kmax + nc2[qposB]) * 1.01f + 1.0f);
            u32x4 qxw; qxw.x = hi ? 0u : 0x3f803f80u; qxw.y = hi ? 0u : (0x00003f80u | ((mbA ^ 0x8000u) << 16)); qxw.z = 0u; qxw.w = 0u;
            const bf16x8 qxA = __builtin_bit_cast(bf16x8, qxw);
            qxw.y = hi ? 0u : (0x00003f80u | ((mbB ^ 0x8000u) << 16));
            const bf16x8 qxB = __builtin_bit_cast(bf16x8, qxw);
            unsigned kofs[4];
#pragma unroll
            for (int d0 = 0; d0 < 4; ++d0) kofs[d0] = lds0 + r32 * 128 + (((2 * d0 + hi) ^ ((r32 >> 1) & 7)) << 4);
            const unsigned vbo = lds0 + 32768 + ((lane >> 4) & 1) * 32 + (lane & 3) * 8 + (4 * hi + ((lane & 15) >> 2)) * 64;
            const unsigned kxo = lds0 + 65536 + r32 * 16;
            const int krow = 8 * wave + (lane >> 3);
            const unsigned kdma = (unsigned)krow * (FKVW * 2) + (((lane & 7) ^ ((krow >> 1) & 7)) << 4);
            const unsigned vdma = (unsigned)(16 * (wave & 3) + (lane >> 2)) * (FKVW * 2) + (wave >> 2) * 64 + (lane & 3) * 16;
            const unsigned kdst = lds0 + wave * 1024, vdst = lds0 + 32768 + wave * 1024;
            Acc aA, aB; acc_init(aA); acc_init(aB);
#define FOX_DMA_K(t) glds16s(kdma, Kg + (size_t)(t) * 64 * FKVW, (unsigned)__builtin_amdgcn_readfirstlane(kdst + ((t) & 3) * 8192))
#define FOX_DMA_V(t) glds16s(vdma, Vg + (size_t)(t) * 64 * FKVW, (unsigned)__builtin_amdgcn_readfirstlane(vdst + ((t) & 3) * 8192))
            asm volatile("s_waitcnt vmcnt(0) lgkmcnt(0)\n\ts_barrier" ::: "memory");
            FOX_DMA_K(0); FOX_DMA_V(0); FOX_DMA_K(1); FOX_DMA_V(1);
#define FOX_PREFIX(t) \
            if ((t) + 1 < NT) asm volatile("s_waitcnt vmcnt(2) lgkmcnt(0)\n\ts_barrier" ::: "memory"); \
            else asm volatile("s_waitcnt vmcnt(0) lgkmcnt(0)\n\ts_barrier" ::: "memory");     \
            if ((t) + 2 < NT) { FOX_DMA_K((t) + 2); FOX_DMA_V((t) + 2); }
#define FOX_STEP(t, DIAG) do { \
            const unsigned so = (unsigned)((t) & 3) * 8192u; \
            const unsigned kxa = kxo + (unsigned)(t) * 1024u; \
            const bf16x8 x0 = *(LAS const bf16x8*)(uintptr_t)kxa, x1 = *(LAS const bf16x8*)(uintptr_t)(kxa + 512); \
            f32x16 a0, a1, b0, b1; \
            if (DIAG) { const int k0_ = 64 * (t); \
                _Pragma("unroll") for (int r = 0; r < 16; ++r) { const int key = k0_ + crow(r, hi); a0[r] = (key > qposA) ? NEG : 0.f; a1[r] = (key + 32 > qposA) ? NEG : 0.f; b0[r] = (key > qposB) ? NEG : 0.f; b1[r] = (key + 32 > qposB) ? NEG : 0.f; } } \
            else { _Pragma("unroll") for (int r = 0; r < 16; ++r) { a0[r] = 0.f; a1[r] = 0.f; b0[r] = 0.f; b1[r] = 0.f; } } \
            _Pragma("unroll") for (int d0 = 0; d0 < 4; ++d0) { \
                const bf16x8 k0f = *(LAS const bf16x8*)(uintptr_t)(kofs[d0] + so), k1f = *(LAS const bf16x8*)(uintptr_t)(kofs[d0] + so + 4096); \
                a0 = __builtin_amdgcn_mfma_f32_32x32x16_bf16(k0f, qfA[d0], a0, 0, 0, 0); a1 = __builtin_amdgcn_mfma_f32_32x32x16_bf16(k1f, qfA[d0], a1, 0, 0, 0); \
                b0 = __builtin_amdgcn_mfma_f32_32x32x16_bf16(k0f, qfB[d0], b0, 0, 0, 0); b1 = __builtin_amdgcn_mfma_f32_32x32x16_bf16(k1f, qfB[d0], b1, 0, 0, 0); } \
            a0 = __builtin_amdgcn_mfma_f32_32x32x16_bf16(x0, qxA, a0, 0, 0, 0); a1 = __builtin_amdgcn_mfma_f32_32x32x16_bf16(x1, qxA, a1, 0, 0, 0); \
            b0 = __builtin_amdgcn_mfma_f32_32x32x16_bf16(x0, qxB, b0, 0, 0, 0); b1 = __builtin_amdgcn_mfma_f32_32x32x16_bf16(x1, qxB, b1, 0, 0, 0); \
            bf16x8 paA[4], paB[4]; \
            exp_pack<false>(aA.l, a0, a1, paA, true); \
            exp_pack<false>(aB.l, b0, b1, paB, true); \
            const unsigned va = vbo + so; \
            _Pragma("unroll") for (int d0 = 0; d0 < 2; ++d0) _Pragma("unroll") for (int ks = 0; ks < 4; ++ks) { \
                const s16x4 lo = vtr((lptr)(uintptr_t)(va + d0 * 4096 + ks * 1024)), hh = vtr((lptr)(uintptr_t)(va + d0 * 4096 + ks * 1024 + 512)); \
                const bf16x8 vf = (bf16x8){lo[0], lo[1], lo[2], lo[3], hh[0], hh[1], hh[2], hh[3]}; \
                aA.o[d0] = __builtin_amdgcn_mfma_f32_32x32x16_bf16(paA[ks], vf, aA.o[d0], 0, 0, 0); \
                aB.o[d0] = __builtin_amdgcn_mfma_f32_32x32x16_bf16(paB[ks], vf, aB.o[d0], 0, 0, 0); } } while (0)
            int t = 0;
#pragma unroll 1
            for (; t + 1 < nact; ++t) { FOX_PREFIX(t) FOX_STEP(t, false); }
            { FOX_PREFIX(t) FOX_STEP(t, true); ++t; }
#pragma unroll 1
            for (; t < NT; ++t) { FOX_PREFIX(t) }
#undef FOX_STEP
#undef FOX_PREFIX
#undef FOX_DMA_K
#undef FOX_DMA_V
            LAS unsigned short* stg = (LAS unsigned short*)(lds + 110592) + wave * 2048;
            f32x16 res[2];
#pragma unroll
            for (int r = 0; r < 16; ++r) { res[0][r] = 0.f; res[1][r] = 0.f; }
            acc_merge(res, aA, 1.0f, wsf, r32, hi);
            store_o_lds(res, O, rowb + q0, h * 64, stg, lane, r32, hi);
#pragma unroll
            for (int r = 0; r < 16; ++r) { res[0][r] = 0.f; res[1][r] = 0.f; }
            acc_merge(res, aB, 1.0f, wsf, r32, hi);
            store_o_lds(res, O, rowb + q0 + 32, h * 64, stg, lane, r32, hi);
        }
    }
}

#define WAIT_BAR() asm volatile("s_waitcnt vmcnt(0) lgkmcnt(0)\n\ts_barrier" ::: "memory")
#define LGKM0() asm volatile("s_waitcnt lgkmcnt(0)" ::: "memory")
__device__ __forceinline__ void nsa_phase4(LAS unsigned char* lds, const bf16* Q, const bf16* KV, const bf16* KC, const bf16* VC, const float* GATE, const float* TBL, bf16* O) {
    const int tid0 = threadIdx.x, wave = __builtin_amdgcn_readfirstlane(tid0 >> 6);
    const int hh = wave >> 1, rhalf = wave & 1;
    const unsigned lds0 = (unsigned)(uintptr_t)lds;
    LAS float* T = (LAS float*)(lds + 65536);
    LAS float* wsf0 = (LAS float*)(lds + 77824) + wave * 64;
    LAS float* score = (LAS float*)(lds + 79872);
    LAS unsigned* maskl = (LAS unsigned*)(lds + 88064);
    LAS unsigned char* park0 = lds + 90112 + wave * 8192;
    LAS float* imph_w = (LAS float*)(lds + 90112 + hh * 8192);
    const int Gd = gridDim.x;
    const bool bal = (Gd == 256);
    const int vc = bal ? ((blockIdx.x & 7) * 32 + (blockIdx.x >> 3)) : (int)blockIdx.x;
    const int nun = bal ? 8 : (2048 - vc + Gd - 1) / Gd;
    int gcur = -1, bgcur = -1;
    float bmaxw = 0.f, kmax_sel = 0.f, kmax_win = 0.f;
    for (int ui = 0; ui < nun; ++ui) {
        int tid = tid0; asm volatile("" : "+v"(tid));
        const int lane = tid & 63, r32 = lane & 31, hi = lane >> 5;
        LAS float* wsf = wsf0; LAS unsigned char* park = park0;
        int bg, qb;
        if (bal) { bg = vc >> 2; const int sub = vc & 3, pr = ui >> 1; qb = 8 * pr + ((ui & 1) ? (7 - sub) : sub); }
        else { const int u = vc + ui * Gd; bg = u >> 5; qb = u & 31; }
        const int b = bg >> 2, g = bg & 3, head = 4 * g + hh;
        const size_t rowb = (size_t)b * S;
        const int q0 = 64 * qb + 32 * rhalf, qpos = q0 + r32;
        const bf16* Ksel = uni(KV + rowb * KVW + 2 * 256 + g * 64); const bf16* Kwin = Ksel + 2 * 256;
        WAIT_BAR();
        if (g != gcur) { for (int i = tid; i < 4 * TLEN; i += 512) T[i] = TBL[g * 4 * TLEN + i]; }
        if (bg != bgcur) {
            float ks = 0.f, kw = 0.f;
#pragma unroll
            for (int i = 0; i < 4; ++i) { const u32x4* k1 = (const u32x4*)(Ksel + (size_t)(4 * tid + i) * KVW); const u32x4* k2 = (const u32x4*)(Kwin + (size_t)(4 * tid + i) * KVW); float s1 = 0.f, s2 = 0.f;
#pragma unroll
                for (int c = 0; c < 8; ++c) { const u32x4 w = k1[c], x = k2[c];
                    { const float a0 = __uint_as_float(w.x << 16), a1 = __uint_as_float(w.x & 0xffff0000u), a2 = __uint_as_float(w.y << 16), a3 = __uint_as_float(w.y & 0xffff0000u);
                      const float a4 = __uint_as_float(w.z << 16), a5 = __uint_as_float(w.z & 0xffff0000u), a6 = __uint_as_float(w.w << 16), a7 = __uint_as_float(w.w & 0xffff0000u);
                      s1 += (a0 * a0 + a1 * a1) + (a2 * a2 + a3 * a3) + (a4 * a4 + a5 * a5) + (a6 * a6 + a7 * a7); }
                    { const float a0 = __uint_as_float(x.x << 16), a1 = __uint_as_float(x.x & 0xffff0000u), a2 = __uint_as_float(x.y << 16), a3 = __uint_as_float(x.y & 0xffff0000u);
                      const float a4 = __uint_as_float(x.z << 16), a5 = __uint_as_float(x.z & 0xffff0000u), a6 = __uint_as_float(x.w << 16), a7 = __uint_as_float(x.w & 0xffff0000u);
                      s2 += (a0 * a0 + a1 * a1) + (a2 * a2 + a3 * a3) + (a4 * a4 + a5 * a5) + (a6 * a6 + a7 * a7); } }
                ks = fmaxf(ks, s1); kw = fmaxf(kw, s2); }
#pragma unroll
            for (int o = 1; o < 64; o <<= 1) { const float n1 = __shfl_up(ks, o), n2 = __shfl_up(kw, o); if (lane >= o) { ks = fmaxf(ks, n1); kw = fmaxf(kw, n2); } }
            if (lane == 63) { score[wave] = ks; score[8 + wave] = kw; }
            WAIT_BAR();
            ks = score[0]; kw = score[8];
#pragma unroll
            for (int w = 1; w < 8; ++w) { ks = fmaxf(ks, score[w]); kw = fmaxf(kw, score[8 + w]); }
            kmax_sel = sqrtf(ks); kmax_win = sqrtf(kw);
            bgcur = bg;
        }
        const int ncmp = (qb >= 16) ? 2 : 1;
        const bf16* kcg = KC + (size_t)bg * 128 * 64; const bf16* vcg = VC + (size_t)bg * 128 * 64;
        dma_kv(lds + 16384, lds + 32768 + 16384, kcg, vcg, 64, wave, lane);
        if (ncmp == 2) dma_kv(lds + 24576, lds + 32768 + 24576, kcg + 64 * 64, vcg + 64 * 64, 64, wave, lane);
        const int NSEL = qb + 1, jlo = (qb >= 8) ? qb - 8 : 0, NT = NSEL + (qb - jlo + 1);
        const int krow = 8 * wave + (lane >> 3);
        const unsigned kdma = (unsigned)krow * (KVW * 2) + (((lane & 7) ^ ((krow >> 1) & 7)) << 4);
        const unsigned vdma = (unsigned)(16 * (wave & 3) + (lane >> 2)) * (KVW * 2) + (wave >> 2) * 64 + (lane & 3) * 16;
        const unsigned kdst = lds0 + wave * 1024, vdst = lds0 + 32768 + wave * 1024;
#define NSA_KBASE(n) (((n) < NSEL) ? Ksel + (size_t)(n) * 64 * KVW : Kwin + (size_t)(jlo + (n) - NSEL) * 64 * KVW)
#define NSA_DMA_K(n) do { const bf16* kb_ = NSA_KBASE(n); glds16s(kdma, kb_, (unsigned)__builtin_amdgcn_readfirstlane(kdst + ((n) & 3) * 8192)); } while (0)
#define NSA_DMA_V(n) do { const bf16* kb_ = NSA_KBASE(n); glds16s(vdma, kb_ + 256, (unsigned)__builtin_amdgcn_readfirstlane(vdst + ((n) & 3) * 8192)); } while (0)
        NSA_DMA_K(0); NSA_DMA_V(0); NSA_DMA_K(1); NSA_DMA_V(1);
        bf16x8 qf[4];
#pragma unroll
        for (int d0 = 0; d0 < 4; ++d0) qf[d0] = *(const bf16x8*)(Q + (rowb + qpos) * D + head * 64 + d0 * 16 + hi * 8);
        const float* gp = GATE + (rowb + qpos) * 48 + head;
        const float g0 = gp[0], g1 = gp[16], g2 = gp[32];
        f32x16 res[2];
#pragma unroll
        for (int r = 0; r < 16; ++r) { res[0][r] = 0.f; res[1][r] = 0.f; }
        LAS const float* Th = T + hh * TLEN;
        WAIT_BAR();
        if (g != gcur) {
            float bm = fmaxf(fmaxf(Th[63 + lane], Th[127 + lane]), 0.f);
#pragma unroll
            for (int o = 1; o < 64; o <<= 1) { const float n1 = __shfl_up(bm, o); if (lane >= o) bm = fmaxf(bm, n1); }
            bmaxw = __shfl(bm, 63);
            gcur = g;
        }
        {
            f32x16 p0, p1;
#define CMP_SCORES(tile) do { _Pragma("unroll") for (int r = 0; r < 16; ++r) { const int c = crow(r, hi); \
                int da = qpos - 16 * c - 31 - 1024 * (tile), db = da - 512; \
                da = da < -63 ? -63 : (da > 128 ? 128 : da); db = db < -63 ? -63 : (db > 128 ? 128 : db); \
                p0[r] = Th[da + 63]; p1[r] = Th[db + 63]; } \
                qk(p0, p1, lds + 16384 + (tile) * 8192, qf, r32, hi); } while (0)
            float rm = NEG;
            CMP_SCORES(0);
#pragma unroll
            for (int r = 0; r < 16; ++r) rm = fmaxf(rm, fmaxf(p0[r], p1[r]));
            if (ncmp == 2) {
                CMP_SCORES(1);
#pragma unroll
                for (int r = 0; r < 16; ++r) rm = fmaxf(rm, fmaxf(p0[r], p1[r]));
            }
            rm = fmaxf(rm, xhalf(rm));
            const float mm = fmaxf(rm, -1.0e30f);
            float sum = 0.f, tBprev = 0.f;
            float impv[16];
            Acc a; acc_init(a);
            lptr vb = lds + 32768 + 16384 + ((lane >> 4) & 1) * 32 + (lane & 3) * 8 + (4 * hi + ((lane & 15) >> 2)) * 64;
#define IMP_GROUP(P, i, n) do { const float e0 = P[4 * (i)], e1 = P[4 * (i) + 1], e2 = P[4 * (i) + 2], e3 = P[4 * (i) + 3]; \
                const float A = 2.0f * (e0 + e1 + e2) + e3; const float tB = xhalf(e3); \
                impv[n] = A + (hi ? tB : tBprev); tBprev = tB; } while (0)
#define CMP_PASS2(tile) do { \
                _Pragma("unroll") for (int r = 0; r < 16; ++r) { p0[r] = __builtin_amdgcn_exp2f(p0[r] - mm); p1[r] = __builtin_amdgcn_exp2f(p1[r] - mm); sum += p0[r] + p1[r]; } \
                if (qb >= 16) { _Pragma("unroll") for (int i = 0; i < 4; ++i) IMP_GROUP(p0, i, 8 * (tile) + i); \
                _Pragma("unroll") for (int i = 0; i < 4; ++i) IMP_GROUP(p1, i, 8 * (tile) + 4 + i); } \
                bf16x8 pa[4]; \
                _Pragma("unroll") for (int s2 = 0; s2 < 2; ++s2) { u32x4 w0, w1; \
                    w0.x = cvtpk(p0[8 * s2 + 0], p0[8 * s2 + 1]); w0.y = cvtpk(p0[8 * s2 + 2], p0[8 * s2 + 3]); w0.z = cvtpk(p0[8 * s2 + 4], p0[8 * s2 + 5]); w0.w = cvtpk(p0[8 * s2 + 6], p0[8 * s2 + 7]); \
                    w1.x = cvtpk(p1[8 * s2 + 0], p1[8 * s2 + 1]); w1.y = cvtpk(p1[8 * s2 + 2], p1[8 * s2 + 3]); w1.z = cvtpk(p1[8 * s2 + 4], p1[8 * s2 + 5]); w1.w = cvtpk(p1[8 * s2 + 6], p1[8 * s2 + 7]); \
                    pa[s2] = __builtin_bit_cast(bf16x8, w0); pa[2 + s2] = __builtin_bit_cast(bf16x8, w1); } \
                _Pragma("unroll") for (int d0 = 0; d0 < 2; ++d0) \
                _Pragma("unroll") for (int ks = 0; ks < 4; ++ks) { const s16x4 lo = vtr(vb + (tile) * 8192 + d0 * 4096 + ks * 1024), hv = vtr(vb + (tile) * 8192 + d0 * 4096 + ks * 1024 + 512); \
                    const bf16x8 vf = (bf16x8){lo[0], lo[1], lo[2], lo[3], hv[0], hv[1], hv[2], hv[3]}; \
                    a.o[d0] = __builtin_amdgcn_mfma_f32_32x32x16_bf16(pa[ks], vf, a.o[d0], 0, 0, 0); } } while (0)
            if (ncmp == 2) { CMP_SCORES(0); }
            CMP_PASS2(0);
            if (ncmp == 2) { CMP_SCORES(1); CMP_PASS2(1); }
            else {
#pragma unroll
                for (int n = 8; n < 16; ++n) impv[n] = 0.f;
            }
#undef CMP_SCORES
#undef IMP_GROUP
#undef CMP_PASS2
            const float lt = sum + xhalf(sum), inv = 1.0f / fmaxf(lt, 1e-30f);
            LAS float* ip = imph_w + (size_t)(rhalf * 32 + r32) * 32 + hi;
            if (qb >= 16) {
#pragma unroll
                for (int n = 0; n < 16; ++n) ip[2 * n] = impv[n] * inv;
            }
            a.l = 0.5f * lt;
            acc_merge(res, a, g0, wsf, r32, hi);
        }
        if (qb >= 16) WAIT_BAR();
        if (qb >= 16) {
            int tk = tid; asm volatile("" : "+v"(tk));
            const int row = tk >> 3, part = tk & 7;
            LAS const float* i0 = (LAS const float*)(lds + 90112) + row * 32, * i1 = (LAS const float*)(lds + 98304) + row * 32, * i2 = (LAS const float*)(lds + 106496) + row * 32, * i3 = (LAS const float*)(lds + 114688) + row * 32;
            u32x4 kc;
#pragma unroll
            for (int e = 0; e < 4; ++e) { const int j = 4 * part + e;
                const float sj = ((i0[j] + i1[j]) + i2[j]) + i3[j];
                const bool visible = j <= qb, forced = (j == 0) || (j == qb) || (j == qb - 1);
                const float scv = visible ? (forced ? 1.0e9f : sj) : -1.0e30f;
                const unsigned ub = __float_as_uint(scv), so = (ub & 0x80000000u) ? ~ub : (ub | 0x80000000u);
                kc[e] = (so & ~31u) | (unsigned)(31 - j); }
            LAS unsigned* skey = (LAS unsigned*)score;
            *(LAS u32x4*)(skey + row * 32 + 4 * part) = kc;
            LGKM0();
            int rk0 = 0, rk1 = 0, rk2 = 0, rk3 = 0;
#pragma unroll
            for (int i4 = 0; i4 < 8; ++i4) { const u32x4 o4 = *(LAS const u32x4*)(skey + row * 32 + 4 * i4);
#pragma unroll
                for (int e = 0; e < 4; ++e) { const unsigned ki = o4[e];
                    rk0 += (ki > kc[0]) ? 1 : 0; rk1 += (ki > kc[1]) ? 1 : 0; rk2 += (ki > kc[2]) ? 1 : 0; rk3 += (ki > kc[3]) ? 1 : 0; } }
            unsigned nib = (rk0 < 16 ? 1u : 0u) | (rk1 < 16 ? 2u : 0u) | (rk2 < 16 ? 4u : 0u) | (rk3 < 16 ? 8u : 0u);
            unsigned mk = nib << (4 * part);
            mk |= __shfl_xor(mk, 1); mk |= __shfl_xor(mk, 2); mk |= __shfl_xor(mk, 4);
            if (part == 0) maskl[row] = mk;
        }
        unsigned mymask = 0xffffffffu;
        if (qb >= 16) { asm volatile("s_waitcnt lgkmcnt(0)\n\ts_barrier" ::: "memory");
            mymask = maskl[rhalf * 32 + r32]; }
        const float qn = qnorm32(qf);
        const unsigned mbs = (f2bf((qn * kmax_sel + bmaxw) * 1.01f + 1.0f) ^ 0x8000u), mbw = (f2bf((qn * kmax_win + bmaxw) * 1.01f + 1.0f) ^ 0x8000u);
        u32x4 kx1w; kx1w.x = 0x00003f80u; kx1w.y = 0u; kx1w.z = 0u; kx1w.w = 0u;
        const bf16x8 kx1 = __builtin_bit_cast(bf16x8, kx1w);
        unsigned kofs[4];
#pragma unroll
        for (int d0 = 0; d0 < 4; ++d0) kofs[d0] = lds0 + r32 * 128 + (((2 * d0 + hi) ^ ((r32 >> 1) & 7)) << 4);
        const unsigned vbo = lds0 + 32768 + ((lane >> 4) & 1) * 32 + (lane & 3) * 8 + (4 * hi + ((lane & 15) >> 2)) * 64;
        LAS const float* Tq = Th + (q0 + r32) - 4 * hi;
#define NSA_QX(n) u32x4 qxw_; { const bool sel_ = (n) < NSEL; const int j_ = sel_ ? (n) : jlo + (n) - NSEL; const bool ok_ = sel_ ? (((mymask >> j_) & 1u) != 0u) : true; \
            qxw_.x = hi ? 0u : (ok_ ? (sel_ ? mbs : mbw) : 0xff00u); qxw_.y = 0u; qxw_.z = 0u; qxw_.w = 0u; } const bf16x8 qx_ = __builtin_bit_cast(bf16x8, qxw_);
#define NSA_KA(n) unsigned ka[4]; { const unsigned so = (unsigned)((n) & 3) * 8192u; ka[0] = kofs[0] + so; ka[1] = kofs[1] + so; ka[2] = kofs[2] + so; ka[3] = kofs[3] + so; }
#define NSA_ISNEAR(n) ((((n) < NSEL) ? 64 * (n) : 64 * (jlo + (n) - NSEL)) + 63 + 128 > q0 || ((n) >= NSEL && jlo + (n) - NSEL == qb - 8))
#define NSA_SCORES_Z(P0, P1, n) do { NSA_QX(n) NSA_KA(n) qk4z(P0, P1, ka, qf); \
            P0 = __builtin_amdgcn_mfma_f32_32x32x16_bf16(kx1, qx_, P0, 0, 0, 0); P1 = __builtin_amdgcn_mfma_f32_32x32x16_bf16(kx1, qx_, P1, 0, 0, 0); } while (0)
#define NSA_SCORES_G(P0, P1, n) do { NSA_QX(n) NSA_KA(n) const int k0_ = ((n) < NSEL) ? 64 * (n) : 64 * (jlo + (n) - NSEL); f32x16 ci0, ci1; gather_c(ci0, ci1, Tq - k0_); \
            qk4c(P0, P1, ci0, ci1, ka, qf); \
            P0 = __builtin_amdgcn_mfma_f32_32x32x16_bf16(kx1, qx_, P0, 0, 0, 0); P1 = __builtin_amdgcn_mfma_f32_32x32x16_bf16(kx1, qx_, P1, 0, 0, 0); } while (0)
        Acc a; acc_init(a);
#define NSA_PREFIX(n) \
        if ((n) + 1 < NT) asm volatile("s_waitcnt vmcnt(2) lgkmcnt(0)\n\ts_barrier" ::: "memory"); \
        else asm volatile("s_waitcnt vmcnt(0) lgkmcnt(0)\n\ts_barrier" ::: "memory");     \
        if ((n) + 2 < NT) { NSA_DMA_K((n) + 2); NSA_DMA_V((n) + 2); } \
        if ((n) == NSEL) { acc_merge(res, a, g1, wsf, r32, hi); acc_init(a); }
#pragma unroll 1
        for (int n = 0; n < NT; ++n) {
            NSA_PREFIX(n)
            f32x16 c0, c1; bf16x8 pa[4];
            if (!NSA_ISNEAR(n)) {
                NSA_SCORES_Z(c0, c1, n);
                exp_pack<false>(a.l, c0, c1, pa, true);
                pv4(a.o, pa, vbo + (unsigned)(n & 3) * 8192u);
            } else {
                NSA_SCORES_G(c0, c1, n);
                exp_pack<false>(a.l, c0, c1, pa, true);
                pv4(a.o, pa, vbo + (unsigned)(n & 3) * 8192u);
            }
        }
#undef NSA_PREFIX
#undef NSA_SCORES_Z
#undef NSA_SCORES_G
#undef NSA_ISNEAR
#undef NSA_KA
#undef NSA_QX
#undef NSA_DMA_K
#undef NSA_DMA_V
#undef NSA_KBASE
        acc_merge(res, a, g2, wsf, r32, hi);
        store_o_lds(res, O, rowb + q0, head * 64, (LAS unsigned short*)park, lane, r32, hi);
    }
}
#undef WAIT_BAR
#undef LGKM0
}

constexpr size_t MiB = 1u << 20;
constexpr size_t WS_SSP = 1 * MiB;
constexpr size_t WS_GATE = 3 * MiB;
constexpr size_t WS_LF = 9 * MiB;
constexpr size_t WS_CUM = 11 * MiB;
constexpr size_t WS_KC = 13 * MiB;
constexpr size_t WS_VC = 14 * MiB;
constexpr size_t WS_MASK = 15 * MiB;
constexpr size_t WS_WIN = 16 * MiB;
constexpr size_t WS_WFOX = 22 * MiB;
constexpr size_t WS_WO0 = 29 * MiB, WS_WO1 = 31 * MiB;
constexpr size_t WS_W1_0 = 33 * MiB, WS_W1_1 = 41 * MiB;
constexpr size_t WS_W2_0 = 49 * MiB, WS_W2_1 = 57 * MiB;
constexpr size_t WS_TBL = 15 * MiB + 512 * 1024;
constexpr size_t WS_WK1 = 65 * MiB;
constexpr size_t WS_XB = 66 * MiB;
constexpr size_t WS_A = 130 * MiB;
constexpr size_t WS_Q = WS_A;
constexpr size_t WS_KV = WS_A + 64 * MiB;
constexpr size_t WS_H = WS_A;
constexpr size_t WS_END = 386 * MiB;

constexpr int NWAVES = 8;
constexpr int LDS_BYTES = 157696;
constexpr int LDS_MISC = 157696 - 64;
constexpr size_t WS_BAR = 0;

#define XB_TMO      128
#define XB_XCNT(j)  (256  + 64 * (j))
#define XB_XSUB(j)  (1280 + 64 * (j))
#define XB_XGEN(j)  (2304 + 64 * (j))
#define XB_TOP      3328
#define XB_TOPGEN   3392
#define XCD_BAR_WORDS 3456
#define XB_SPIN_CAP (1u << 18)

__device__ __forceinline__ unsigned xb_ld(unsigned* p)              { return __hip_atomic_load(p, __ATOMIC_RELAXED, __HIP_MEMORY_SCOPE_AGENT); }
__device__ __forceinline__ unsigned xb_add(unsigned* p, unsigned v) { return __hip_atomic_fetch_add(p, v, __ATOMIC_RELAXED, __HIP_MEMORY_SCOPE_AGENT); }
__device__ __forceinline__ unsigned xb_xcc_id() { return (unsigned)__builtin_amdgcn_s_getreg((3 << 11) | 20) & 0xFu; }
#define XB_SPIN(cond, bar) do { unsigned _sp = 0; while (cond) { __builtin_amdgcn_s_sleep(1); \
    if ((++_sp & 255u) == 0u) { if (xb_ld(&(bar)[XB_TMO])) break; if (_sp > XB_SPIN_CAP) { atomicAdd(&(bar)[XB_TMO], 1u); break; } } } } while (0)

struct XcdBarrier {
    unsigned* bar; unsigned x;
    volatile LAS unsigned* st;
};

__device__ __forceinline__ XcdBarrier xcd_barrier_post(unsigned* bar, volatile LAS unsigned* st) {
    XcdBarrier b; b.bar = bar; b.x = xb_xcc_id(); b.st = st;
    if (threadIdx.x == 0) (void)xb_add(&bar[XB_XCNT(b.x)], 1u);
    return b;
}
__device__ __forceinline__ void xcd_barrier_complete(unsigned* bar, unsigned x, unsigned& nloc, unsigned& nx) {
    const unsigned G = gridDim.x * gridDim.y * gridDim.z;
    unsigned sum, cnt, mine, sp = 0u;
    for (;;) {
        sum = 0u; cnt = 0u; mine = 0u;
#pragma unroll
        for (unsigned j = 0; j < 16; ++j) { const unsigned c = xb_ld(&bar[XB_XCNT(j)]); sum += c; cnt += (c > 0u) ? 1u : 0u; mine = (j == x) ? c : mine; }
        if (sum == G) break;
        __builtin_amdgcn_s_sleep(1);
        if ((++sp & 255u) == 0u) { if (xb_ld(&bar[XB_TMO])) break; if (sp > XB_SPIN_CAP) { atomicAdd(&bar[XB_TMO], 1u); break; } }
    }
    nloc = mine > 0u ? mine : 1u; nx = cnt > 0u ? cnt : 1u;
}

__device__ __forceinline__ void xcd_barrier(const XcdBarrier& b) {
    asm volatile("s_waitcnt vmcnt(0)" ::: "memory");
    __syncthreads();
    if (threadIdx.x == 0) {
        unsigned* bar = b.bar;
        __builtin_amdgcn_s_waitcnt(0);
        unsigned nloc = b.st[0], nx = b.st[1];
        if (nloc == 0u) { xcd_barrier_complete(bar, b.x, nloc, nx); b.st[0] = nloc; b.st[1] = nx; }
        const unsigned old = xb_add(&bar[XB_XSUB(b.x)], 1u);
        const unsigned gen = old / nloc;
        if (old + 1u == (gen + 1u) * nloc) {
            __builtin_amdgcn_fence(__ATOMIC_RELEASE, "agent");
            asm volatile("s_waitcnt vmcnt(0)" ::: "memory");
            const unsigned og = xb_add(&bar[XB_TOP], 1u);
            const unsigned tg = og / nx;
            if (og + 1u == (tg + 1u) * nx) xb_add(&bar[XB_TOPGEN], 1u);
            else XB_SPIN(xb_ld(&bar[XB_TOPGEN]) == tg, bar);
            __builtin_amdgcn_fence(__ATOMIC_ACQUIRE, "agent");
            xb_add(&bar[XB_XGEN(b.x)], 1u);
            asm volatile("s_waitcnt vmcnt(0)" ::: "memory");
        } else {
            XB_SPIN(xb_ld(&bar[XB_XGEN(b.x)]) == gen, bar);
            __builtin_amdgcn_fence(__ATOMIC_ACQUIRE, "agent");
            asm volatile("s_waitcnt vmcnt(0)" ::: "memory");
        }
    }
    __syncthreads();
}

enum Phase { PH_PRO = 0, PH_NSA_IN, PH_CMP, PH_NSA_ATT, PH_NSA_OUT, PH_UP0, PH_DN0, PH_FOX_IN, PH_FOX_ATT, PH_FOX_OUT, PH_UP1, PH_DN1, PH_FINAL, PH_COUNT };
struct Params { const float* in[18]; float* out; unsigned char* ws; int ph_lo, ph_hi; };
enum { I_X = 0, I_RELB, I_NMIX, I_NMLP, I_NSA_WIN, I_PEK, I_WK1, I_WK2, I_PEV, I_WV1, I_WV2, I_NSA_WOUT, I_FOX_WIN, I_FOX_BF, I_FOX_WOUT, I_W1, I_W2, I_FNORM };

__device__ __forceinline__ void phase_prologue(const Params& p, LAS unsigned char* lds, int gw, int NGW, int wave, int lane) {
    LAS float* scr = (LAS float*)(lds + wave * 16384);
    unsigned char* ws = p.ws;
    int base = 0;
#define TMAT(Wp, gainp, K_, N_, NP_, off_) TMATF(false, Wp, gainp, K_, N_, NP_, off_)
#define TMATF(FR_, Wp, gainp, K_, N_, NP_, off_) do { const int nblk = (NP_) / 32, nitems = ((K_) / 64) * nblk; \
        int first = gw - (base % NGW); if (first < 0) first += NGW; \
        for (int it = first; it < nitems; it += NGW) transpose_item<FR_>((Wp), (gainp), (K_), (N_), (bf16*)(ws + (off_)), scr, it, nblk, lane); \
        base += nitems; } while (0)
    TMAT(p.in[I_NSA_WIN], p.in[I_NMIX], D, NSA_IN, NSA_INP, WS_WIN);
    TMAT(p.in[I_FOX_WIN], p.in[I_NMIX] + D, D, FOX_IN, FOX_INP, WS_WFOX);
    TMAT(p.in[I_NSA_WOUT], (const float*)nullptr, D, D, D, WS_WO0);
    TMAT(p.in[I_FOX_WOUT], (const float*)nullptr, D, D, D, WS_WO1);
    TMAT(p.in[I_W1], p.in[I_NMLP], D, DFF, DFF, WS_W1_0);
    TMAT(p.in[I_W1] + (size_t)D * DFF, p.in[I_NMLP] + D, D, DFF, DFF, WS_W1_1);
    TMAT(p.in[I_W2], (const float*)nullptr, DFF, D, D, WS_W2_0);
    TMAT(p.in[I_W2] + (size_t)DFF * D, (const float*)nullptr, DFF, D, D, WS_W2_1);
    TMATF(true, p.in[I_WK1], (const float*)nullptr, 2048, 64, 64, WS_WK1);
    TMATF(true, p.in[I_WV1], (const float*)nullptr, 2048, 64, 64, WS_WK1 + 64 * 2048 * 2);
#undef TMAT
#undef TMATF
    {
        const float* relb = p.in[I_RELB]; float* TBL = (float*)(ws + WS_TBL);
        for (int i = gw * 64 + lane; i < 16 * 704; i += NGW * 64) { const int h = i / 704, dist = i % 704 - 63; float v;
            if (dist < 0) v = -3.0e38f; else if (dist < 128) v = (relb[rel_bucket(dist) * 16 + h] - relb[31 * 16 + h]) * LOG2E; else if (dist < 512) v = 0.f; else v = -3.0e38f;
            TBL[i] = v; }
    }
    const float* x = p.in[I_X]; bf16* XB = (bf16*)(ws + WS_XB); float* SSP = (float*)(ws + WS_SSP);
    for (int m = 4 * gw; m < M; m += 4 * NGW) xrow4_item(x, XB, SSP, m, lane);
}


__global__ void __launch_bounds__(NWAVES * 64, 2) mega(Params p) {
    extern __shared__ __attribute__((aligned(16))) unsigned char lds_raw[];
    LAS unsigned char* lds = (LAS unsigned char*)lds_raw;
    const int tid = threadIdx.x, lane = tid & 63, wave = __builtin_amdgcn_readfirstlane(tid >> 6);
    const int Gd = gridDim.x, gw = blockIdx.x * NWAVES + wave, NGW = Gd * NWAVES;
    unsigned char* ws = p.ws;
    const int lo = p.ph_lo, hi = p.ph_hi;
    cg::grid_group grid = cg::this_grid();
    volatile LAS unsigned* MISC = (volatile LAS unsigned*)(lds + LDS_MISC);
    if (tid < 16) MISC[tid] = 0u;
    __syncthreads();
    XcdBarrier xbar = xcd_barrier_post((unsigned*)(ws + WS_BAR), MISC);
#define IN(k) (lo <= (k) && (k) < hi)
#define SEAM(k) do { if (IN(k) && IN((k) + 1)) xcd_barrier(xbar); } while (0)
    if (hi < 0) grid.sync();
    bf16* XB = (bf16*)(ws + WS_XB); float* SSP = (float*)(ws + WS_SSP);
    if (IN(PH_PRO)) { phase_prologue(p, lds, gw, NGW, wave, lane); }
    SEAM(PH_PRO);
    if (IN(PH_NSA_IN)) {
        pg8::Gemm g{XB, (const bf16*)(ws + WS_WIN), M, 2560, D}; pg8::StaticOrder So; So.init(M, 2560, Gd, (int)blockIdx.x);
        LAS float* rsl = (LAS float*)(lds + pg8::STAGE_BYTES); rstd_prepare(rsl, SSP, So);
        EpiNsaIn E{(bf16*)(ws + WS_Q), (bf16*)(ws + WS_KV), (float*)(ws + WS_GATE), rsl, 0};
        pg8::gemm_phase<EpiNsaIn, pg8::StaticOrder, true, true>(lds, g, So, E);
        skinny_cols<0>(XB, (const bf16*)(ws + WS_WIN) + (size_t)2560 * D, SSP, nullptr, (float*)(ws + WS_GATE), wave * Gd + (int)blockIdx.x, NGW, lane);
    }
    SEAM(PH_NSA_IN);
    if (IN(PH_CMP)) { att::compress_phase(lds, (const bf16*)(ws + WS_KV), p.in[I_PEK], p.in[I_PEV], (const bf16*)(ws + WS_WK1), p.in[I_WK2], p.in[I_WV2], (bf16*)(ws + WS_KC), (bf16*)(ws + WS_VC)); }
    SEAM(PH_CMP);
    if (IN(PH_NSA_ATT)) { att::nsa_phase4(lds, (const bf16*)(ws + WS_Q), (const bf16*)(ws + WS_KV), (const bf16*)(ws + WS_KC), (const bf16*)(ws + WS_VC), (const float*)(ws + WS_GATE), (const float*)(ws + WS_TBL), (bf16*)(ws + WS_Q)); }
    SEAM(PH_NSA_ATT);
    if (IN(PH_NSA_OUT)) {
        pg8::Gemm g{(const bf16*)(ws + WS_Q), (const bf16*)(ws + WS_WO0), M, D, D}; pg8::StaticOrder So; So.init(M, D, Gd, (int)blockIdx.x);
        EpiResid<true> E{p.in[I_X], XB, SSP};
        pg8::gemm_phase<EpiResid<true>, pg8::StaticOrder, true, true>(lds, g, So, E);
    }
    SEAM(PH_NSA_OUT);
    if (IN(PH_UP0)) {
        {   pg8::Gemm g{XB + (size_t)0 * (M / 2) * D, (const bf16*)(ws + WS_W1_0), M / 2, DFF, D}; pg8::StaticOrder So; So.init(M / 2, DFF, Gd, (int)blockIdx.x);
            LAS float* rsl = (LAS float*)(lds + pg8::STAGE_BYTES); rstd_prepare(rsl, SSP + (size_t)0 * (M / 2) * 16, So);
            EpiRelu2 E{(bf16*)(ws + WS_H), rsl, 0};
            pg8::gemm_phase<EpiRelu2, pg8::StaticOrder, true, true>(lds, g, So, E); }
        xcd_barrier(xbar);
        {   pg8::Gemm g{(const bf16*)(ws + WS_H), (const bf16*)(ws + WS_W2_0), M / 2, D, DFF}; pg8::StaticOrder So; So.init(M / 2, D, Gd, (int)blockIdx.x);
            EpiResid<false> E{nullptr, XB + (size_t)0 * (M / 2) * D, SSP + (size_t)0 * (M / 2) * 16};
            pg8::gemm_phase<EpiResid<false>, pg8::StaticOrder, true, true>(lds, g, So, E); }
        xcd_barrier(xbar);
        {   pg8::Gemm g{XB + (size_t)1 * (M / 2) * D, (const bf16*)(ws + WS_W1_0), M / 2, DFF, D}; pg8::StaticOrder So; So.init(M / 2, DFF, Gd, (int)blockIdx.x);
            LAS float* rsl = (LAS float*)(lds + pg8::STAGE_BYTES); rstd_prepare(rsl, SSP + (size_t)1 * (M / 2) * 16, So);
            EpiRelu2 E{(bf16*)(ws + WS_H), rsl, 0};
            pg8::gemm_phase<EpiRelu2, pg8::StaticOrder, true, true>(lds, g, So, E); }
        xcd_barrier(xbar);
        {   pg8::Gemm g{(const bf16*)(ws + WS_H), (const bf16*)(ws + WS_W2_0), M / 2, D, DFF}; pg8::StaticOrder So; So.init(M / 2, D, Gd, (int)blockIdx.x);
            EpiResid<false> E{nullptr, XB + (size_t)1 * (M / 2) * D, SSP + (size_t)1 * (M / 2) * 16};
            pg8::gemm_phase<EpiResid<false>, pg8::StaticOrder, true, true>(lds, g, So, E); }
    }
    SEAM(PH_DN0);
    if (IN(PH_FOX_IN)) {
        pg8::Gemm g{XB, (const bf16*)(ws + WS_WFOX), M, 3072, D}; pg8::StaticOrder So; So.init(M, 3072, Gd, (int)blockIdx.x);
        LAS float* rsl = (LAS float*)(lds + pg8::STAGE_BYTES); rstd_prepare(rsl, SSP, So);
        EpiFoxIn E{(bf16*)(ws + WS_Q), (bf16*)(ws + WS_KV), (float*)(ws + WS_LF), rsl, p.in[I_FOX_BF], 0};
        pg8::gemm_phase<EpiFoxIn, pg8::StaticOrder, true, true>(lds, g, So, E);
        skinny_cols<1>(XB, (const bf16*)(ws + WS_WFOX) + (size_t)3072 * D, SSP, p.in[I_FOX_BF], (float*)(ws + WS_LF), wave * Gd + (int)blockIdx.x, NGW, lane);
    }
    SEAM(PH_FOX_IN);
    if (IN(PH_FOX_ATT)) { att::fox_phase5(lds, (const bf16*)(ws + WS_Q), (const bf16*)(ws + WS_KV), (const float*)(ws + WS_LF), (bf16*)(ws + WS_Q)); }
    SEAM(PH_FOX_ATT);
    if (IN(PH_FOX_OUT)) {
        pg8::Gemm g{(const bf16*)(ws + WS_Q), (const bf16*)(ws + WS_WO1), M, D, D}; pg8::StaticOrder So; So.init(M, D, Gd, (int)blockIdx.x);
        EpiResid<false> E{nullptr, XB, SSP};
        pg8::gemm_phase<EpiResid<false>, pg8::StaticOrder, true, true>(lds, g, So, E);
    }
    SEAM(PH_FOX_OUT);
    if (IN(PH_UP1)) {
        {   pg8::Gemm g{XB + (size_t)0 * (M / 2) * D, (const bf16*)(ws + WS_W1_1), M / 2, DFF, D}; pg8::StaticOrder So; So.init(M / 2, DFF, Gd, (int)blockIdx.x);
            LAS float* rsl = (LAS float*)(lds + pg8::STAGE_BYTES); rstd_prepare(rsl, SSP + (size_t)0 * (M / 2) * 16, So);
            EpiRelu2 E{(bf16*)(ws + WS_H), rsl, 0};
            pg8::gemm_phase<EpiRelu2, pg8::StaticOrder, true, true>(lds, g, So, E); }
        xcd_barrier(xbar);
        {   pg8::Gemm g{(const bf16*)(ws + WS_H), (const bf16*)(ws + WS_W2_1), M / 2, D, DFF}; pg8::StaticOrder So; So.init(M / 2, D, Gd, (int)blockIdx.x);
            EpiFinal E{XB + (size_t)0 * (M / 2) * D, p.out + (size_t)0 * (M / 2) * D, p.in[I_FNORM], (unsigned*)(ws + WS_CUM) + (size_t)0 * (M / 2) * 4, (unsigned*)(ws + 16384) + 0 * 64 * 64};
            pg8::gemm_phase<EpiFinal, pg8::StaticOrder, false, true>(lds, g, So, E); }
        xcd_barrier(xbar);
        {   pg8::Gemm g{XB + (size_t)1 * (M / 2) * D, (const bf16*)(ws + WS_W1_1), M / 2, DFF, D}; pg8::StaticOrder So; So.init(M / 2, DFF, Gd, (int)blockIdx.x);
            LAS float* rsl = (LAS float*)(lds + pg8::STAGE_BYTES); rstd_prepare(rsl, SSP + (size_t)1 * (M / 2) * 16, So);
            EpiRelu2 E{(bf16*)(ws + WS_H), rsl, 0};
            pg8::gemm_phase<EpiRelu2, pg8::StaticOrder, true, true>(lds, g, So, E); }
        xcd_barrier(xbar);
        {   pg8::Gemm g{(const bf16*)(ws + WS_H), (const bf16*)(ws + WS_W2_1), M / 2, D, DFF}; pg8::StaticOrder So; So.init(M / 2, D, Gd, (int)blockIdx.x);
            EpiFinal E{XB + (size_t)1 * (M / 2) * D, p.out + (size_t)1 * (M / 2) * D, p.in[I_FNORM], (unsigned*)(ws + WS_CUM) + (size_t)1 * (M / 2) * 4, (unsigned*)(ws + 16384) + 1 * 64 * 64};
            pg8::gemm_phase<EpiFinal, pg8::StaticOrder, false, true>(lds, g, So, E); }
    }
#undef IN
#undef SEAM
}

extern "C" void kernel_launch(void* const* d_in, const int* in_sizes, int n_in, void* d_out, int out_size, void* d_ws, size_t ws_size, hipStream_t stream) {
    static int grid = 0;
    if (grid == 0) {
        if (n_in != 18 || ws_size < WS_END) { fprintf(stderr, "kernel_launch: unexpected inputs / workspace\n"); grid = -1; return; }
        int dev = 0, cus = 0, per_cu = 0;
        (void)hipGetDevice(&dev); (void)hipDeviceGetAttribute(&cus, hipDeviceAttributeMultiprocessorCount, dev);
        (void)hipFuncSetAttribute((const void*)mega, hipFuncAttributeMaxDynamicSharedMemorySize, LDS_BYTES);
        (void)hipOccupancyMaxActiveBlocksPerMultiprocessor(&per_cu, (const void*)mega, NWAVES * 64, LDS_BYTES);
        if (per_cu < 1) { fprintf(stderr, "kernel_launch: occupancy query reports %d blocks per CU\n", per_cu); grid = -1; return; }
        grid = cus;
    }
    if (grid < 0) return;
    Params p{};
    for (int i = 0; i < 18; ++i) p.in[i] = (const float*)d_in[i];
    p.out = (float*)d_out; p.ws = (unsigned char*)d_ws; p.ph_lo = 0; p.ph_hi = PH_COUNT;
    (void)hipMemsetAsync((char*)d_ws + WS_BAR, 0, 65536, stream);
    void* args[] = {&p};
    hipError_t e = hipLaunchCooperativeKernel((const void*)mega, dim3(grid), dim3(NWAVES * 64), args, LDS_BYTES, stream);
    if (e != hipSuccess) fprintf(stderr, "cooperative launch failed: %s (grid %d)\n", hipGetErrorString(e), grid);
}
```

```cpp
#include <hip/hip_runtime.h>
#include <hip/hip_cooperative_groups.h>
#include <cstdint>
#include <cstdio>
namespace cg = cooperative_groups;

constexpr int D = 1024, NB = 16, S = 2048, NH = 16, DH = 64, G = 4, M = NB * S;
constexpr int NSA_IN = 2608, NSA_INP = 2816, FOX_IN = 3088, FOX_INP = 3328, DFF = 4096, NC = 127;
constexpr int KVW = 1536;
constexpr int FKVW = 2048;
constexpr float LOG2E = 1.4426950408889634f;
constexpr float C2 = 0.125f * LOG2E;
constexpr float RMS_EPS = 1e-6f;

namespace pg8 {
#define PG8_LAS __attribute__((address_space(3)))
typedef unsigned short bf16_t;
typedef short bf16x8 __attribute__((ext_vector_type(8)));
typedef float f32x4 __attribute__((ext_vector_type(4)));
typedef unsigned u32x4 __attribute__((ext_vector_type(4)));
typedef unsigned u32x2 __attribute__((ext_vector_type(2)));
constexpr int BM = 256, BK = 64, HALF = 128, HTB = HALF * BK * 2  , STAGE_BYTES = 8 * HTB, NXCD = 8, WGM = 8;

__host__ __device__ __forceinline__ int lds_byte(int r, int c) { const int st = (r >> 4) * 2 + (c >> 5), rr = r & 15, cc = c & 31, ob = rr * 64 + cc * 2; return st * 1024 + (ob ^ (((ob >> 9) & 1) << 5)); }
__host__ __device__ __forceinline__ void stage_rc(int b, int& R, int& C) { const int st = b / 1024, sb = b % 1024, swz = sb ^ (((sb >> 9) & 1) << 5); R = (st >> 1) * 16 + swz / 64; C = (st & 1) * 32 + (swz % 64) / 2; }
__host__ __device__ __forceinline__ int perm32(int rho) { const int n = rho >> 4, i = rho & 15; return 8 * (i >> 2) + 4 * n + (i & 3); }

struct Unit { int pm, pn; };
struct Gemm { const bf16_t* A; const bf16_t* Bt; int M, N, K; };

struct StaticOrder {
    int nM, nN, nwg, G, c;
    __host__ __device__ void init(int M, int N, int G_, int c_) { nM = M / BM; nN = N / BM; nwg = nM * nN; G = G_; c = c_; }
    __host__ __device__ bool next(int i, Unit& u) const {
        const long L = (long)i * G + c; if (L >= nwg) return false;
        int wgid = (int)L; { const int q = nwg / NXCD, r = nwg % NXCD, xcd = wgid % NXCD, off = wgid / NXCD; wgid = (xcd < r ? xcd * (q + 1) : r * (q + 1) + (xcd - r) * q) + off; }
        const int nig = WGM * nN, gid = wgid / nig, fm = gid * WGM, gsz = (nM - fm) < WGM ? (nM - fm) : WGM;
        u.pm = fm + ((wgid % nig) % gsz); u.pn = (wgid % nig) / gsz; return true;
    }
    __device__ __forceinline__ void a_ready(const Unit&) const {}
    __device__ __forceinline__ void done(const Unit&) const {}
};
__device__ __forceinline__ unsigned cvt_pk_bf16(float lo, float hi) { unsigned r; asm volatile("v_cvt_pk_bf16_f32 %0, %1, %2" : "=v"(r) : "v"(lo), "v"(hi)); return r; }
struct NoPre { __device__ __forceinline__ void operator()() const {} };
template <class Epi, class Sched, bool ALIGN_EPI = false, bool SP2 = false, class Pre = NoPre>
__device__ __forceinline__ void gemm_phase(PG8_LAS unsigned char* lds, const Gemm g, const Sched& S, const Epi& E, const Pre& pre = Pre()) {
    const int tid = threadIdx.x, wid = __builtin_amdgcn_readfirstlane(tid >> 6), lane = tid & 63, wr = wid >> 2, wc = wid & 3, fr = lane & 15, fq = lane >> 4;
    const int K = g.K, nt = K / BK;
    unsigned voffA[2], voffB[2];
#pragma unroll
    for (int i = 0; i < 2; ++i) { int R, C; stage_rc(tid * 16 + i * 8192, R, C); const int Rb = Epi::PERM ? ((R & ~31) + perm32(R & 31)) : R;
        voffA[i] = (unsigned)(R * K + C) * 2u; voffB[i] = (unsigned)(Rb * K + C) * 2u; }
    const size_t kstep = (size_t)(BK * 2);
    const size_t hstep = (size_t)HALF * K * 2;
    const size_t tstep = 2 * hstep;
    const unsigned ldsw = (unsigned)wid * 1024u;
    const int aoff = lds_byte(wr * 64 + fr, fq * 8), boff = lds_byte(wc * 32 + fr, fq * 8);
#define PG8_SA(b, h) (((b) * 2 + (h)) * HTB)
#define PG8_SB(b, h) ((4 + (b) * 2 + (h)) * HTB)
#define PG8_STAGE(bufoff, gbase, voff) do { _Pragma("unroll") for (int _i = 0; _i < 2; ++_i) \
        __builtin_amdgcn_global_load_lds((const unsigned*)((const char*)(gbase) + (voff)[_i]), (PG8_LAS unsigned*)(lds + (bufoff) + ldsw + _i * 8192), 16, 0, 0); } while (0)
#define PG8_LDA(dst, b, h) do { _Pragma("unroll") for (int m = 0; m < 4; ++m) _Pragma("unroll") for (int k = 0; k < 2; ++k) dst[m][k] = *(const PG8_LAS bf16x8*)(lds + PG8_SA(b, h) + aoff + m * 2048 + k * 1024); } while (0)
#define PG8_LDB(dst, b, h) do { _Pragma("unroll") for (int n = 0; n < 2; ++n) _Pragma("unroll") for (int k = 0; k < 2; ++k) dst[n][k] = *(const PG8_LAS bf16x8*)(lds + PG8_SB(b, h) + boff + n * 2048 + k * 1024); } while (0)
#define PG8_MMA(ai, bj, At, Bt) do { __builtin_amdgcn_s_setprio(1); _Pragma("unroll") for (int m = 0; m < 4; ++m) _Pragma("unroll") for (int n = 0; n < 2; ++n) _Pragma("unroll") for (int k = 0; k < 2; ++k) \
        acc[ai][bj][m][n] = __builtin_amdgcn_mfma_f32_16x16x32_bf16(Bt[n][k], At[m][k], acc[ai][bj][m][n], 0, 0, 0); __builtin_amdgcn_s_setprio(0); } while (0)
#define PG8_WAIT_V(n) asm volatile("s_waitcnt vmcnt(" #n ")" ::: "memory")
#define PG8_WAIT_L(n) asm volatile("s_waitcnt lgkmcnt(" #n ")" ::: "memory")
#define PG8_BAR __builtin_amdgcn_s_barrier()
#define PG8_SCHED __builtin_amdgcn_sched_barrier(0)
    Unit cur, nxt; int ui = 0;
    if (!S.next(0, cur)) return;
    f32x4 acc[2][2][4][2];
#pragma unroll
    for (int a = 0; a < 2; ++a)
#pragma unroll
        for (int b = 0; b < 2; ++b)
#pragma unroll
            for (int m = 0; m < 4; ++m)
#pragma unroll
                for (int n = 0; n < 2; ++n) acc[a][b][m][n] = (f32x4){0.f, 0.f, 0.f, 0.f};
    bf16x8 At[4][2], B0[2][2], B1[2][2];
    const char* cA = (const char*)g.A + (size_t)cur.pm * tstep; const char* cB = (const char*)g.Bt + (size_t)cur.pn * tstep;
    S.a_ready(cur);
    if constexpr (SP2) {
        PG8_STAGE(PG8_SB(0, 0), cB, voffB); PG8_STAGE(PG8_SB(0, 1), cB + hstep, voffB); PG8_STAGE(PG8_SA(0, 0), cA, voffA); PG8_STAGE(PG8_SA(0, 1), cA + hstep, voffA);
        pre();
        if (wr == 1) PG8_BAR;
        PG8_WAIT_V(2); PG8_BAR;
        PG8_STAGE(PG8_SB(1, 0), cB + kstep, voffB); PG8_STAGE(PG8_SA(1, 0), cA + kstep, voffA); PG8_STAGE(PG8_SB(1, 1), cB + hstep + kstep, voffB);
        PG8_WAIT_V(6); PG8_BAR;
    } else {
        PG8_STAGE(PG8_SB(0, 0), cB, voffB); PG8_STAGE(PG8_SA(0, 0), cA, voffA); PG8_STAGE(PG8_SB(0, 1), cB + hstep, voffB); PG8_STAGE(PG8_SA(0, 1), cA + hstep, voffA);
        if (wr == 1) PG8_BAR;
        PG8_WAIT_V(4); PG8_BAR;
        PG8_STAGE(PG8_SB(1, 0), cB + kstep, voffB); PG8_STAGE(PG8_SA(1, 0), cA + kstep, voffA); PG8_STAGE(PG8_SB(1, 1), cB + hstep + kstep, voffB);
        PG8_WAIT_V(6); PG8_BAR;
    }
    for (;;) {
        const bool has_next = S.next(ui + 1, nxt);
        const char* nA = has_next ? (const char*)g.A + (size_t)nxt.pm * tstep : cA; const char* nB = has_next ? (const char*)g.Bt + (size_t)nxt.pn * tstep : cB;
        for (int t = 0; t < nt; t += 2) {
            const bool last = (t == nt - 2);
            const char* a1 = cA + (size_t)(t + 1) * kstep;
            const char* a2 = last ? nA : cA + (size_t)(t + 2) * kstep; const char* b2 = last ? nB : cB + (size_t)(t + 2) * kstep;
            const char* a3 = a2 + kstep; const char* b3 = b2 + kstep;
            if (last && has_next) S.a_ready(nxt);
            if constexpr (SP2) {
            PG8_LDB(B0, 0, 0); PG8_LDB(B1, 0, 1); PG8_SCHED; PG8_LDA(At, 0, 0); PG8_STAGE(PG8_SA(1, 1), a1 + hstep, voffA);
            PG8_WAIT_V(8); PG8_WAIT_L(0); PG8_BAR; PG8_MMA(0, 0, At, B0); PG8_MMA(0, 1, At, B1); PG8_BAR; PG8_SCHED;
            PG8_LDA(At, 0, 1); PG8_STAGE(PG8_SB(0, 0), b2, voffB); PG8_STAGE(PG8_SB(0, 1), b2 + hstep, voffB); PG8_STAGE(PG8_SA(0, 0), a2, voffA);
            PG8_WAIT_V(8); PG8_WAIT_L(0); PG8_BAR; PG8_MMA(1, 0, At, B0); PG8_MMA(1, 1, At, B1); PG8_BAR; PG8_SCHED;
            PG8_LDB(B0, 1, 0); PG8_LDB(B1, 1, 1); PG8_SCHED; PG8_LDA(At, 1, 0); PG8_STAGE(PG8_SA(0, 1), a2 + hstep, voffA);
            PG8_WAIT_V(8); PG8_WAIT_L(0); PG8_BAR; PG8_MMA(0, 0, At, B0); PG8_MMA(0, 1, At, B1); PG8_BAR; PG8_SCHED;
            PG8_LDA(At, 1, 1); PG8_STAGE(PG8_SB(1, 0), b3, voffB); PG8_STAGE(PG8_SB(1, 1), b3 + hstep, voffB); PG8_STAGE(PG8_SA(1, 0), a3, voffA);
            PG8_WAIT_V(8); PG8_WAIT_L(0); PG8_BAR; PG8_MMA(1, 0, At, B0); PG8_MMA(1, 1, At, B1); PG8_BAR; PG8_SCHED;
            } else {
            PG8_LDB(B0, 0, 0); PG8_SCHED; PG8_LDA(At, 0, 0); PG8_STAGE(PG8_SA(1, 1), a1 + hstep, voffA);
            PG8_WAIT_L(8); PG8_BAR; PG8_WAIT_L(0); PG8_MMA(0, 0, At, B0); PG8_BAR; PG8_SCHED;
            PG8_LDB(B1, 0, 1); PG8_STAGE(PG8_SB(0, 0), b2, voffB);
            PG8_BAR; PG8_WAIT_L(0); PG8_MMA(0, 1, At, B1); PG8_BAR;
            PG8_LDA(At, 0, 1); PG8_STAGE(PG8_SA(0, 0), a2, voffA);
            PG8_BAR; PG8_WAIT_L(0); PG8_MMA(1, 0, At, B0); PG8_BAR; PG8_SCHED;
            PG8_STAGE(PG8_SB(0, 1), b2 + hstep, voffB);
            PG8_WAIT_V(6); PG8_BAR; PG8_MMA(1, 1, At, B1); PG8_BAR;
            PG8_LDB(B0, 1, 0); PG8_SCHED; PG8_LDA(At, 1, 0); PG8_STAGE(PG8_SA(0, 1), a2 + hstep, voffA);
            PG8_WAIT_L(8); PG8_BAR; PG8_WAIT_L(0); PG8_MMA(0, 0, At, B0); PG8_BAR; PG8_SCHED;
            PG8_LDB(B1, 1, 1); PG8_STAGE(PG8_SB(1, 0), b3, voffB);
            PG8_BAR; PG8_WAIT_L(0); PG8_MMA(0, 1, At, B1); PG8_BAR;
            PG8_LDA(At, 1, 1); PG8_STAGE(PG8_SA(1, 0), a3, voffA);
            PG8_BAR; PG8_WAIT_L(0); PG8_MMA(1, 0, At, B0); PG8_BAR; PG8_SCHED;
            PG8_STAGE(PG8_SB(1, 1), b3 + hstep, voffB);
            PG8_WAIT_V(6); PG8_BAR; PG8_MMA(1, 1, At, B1); PG8_BAR;
            }
        }
        if constexpr (ALIGN_EPI) { if (wr == 0) PG8_BAR; }
        if constexpr (!Epi::AFTER_DRAIN) { E(acc, cur, wr, wc, fr, fq); S.done(cur); }
        if (!has_next) break;
#pragma unroll
        for (int a = 0; a < 2; ++a)
#pragma unroll
            for (int b = 0; b < 2; ++b)
#pragma unroll
                for (int m = 0; m < 4; ++m)
#pragma unroll
                    for (int n = 0; n < 2; ++n) acc[a][b][m][n] = (f32x4){0.f, 0.f, 0.f, 0.f};
        cur = nxt; cA = nA; cB = nB; ++ui;
        if constexpr (ALIGN_EPI) { if (wr == 1) PG8_BAR; }
    }
    PG8_WAIT_V(0);
    if constexpr (!ALIGN_EPI) { if (wr == 0) PG8_BAR; }
    PG8_BAR;
    if constexpr (Epi::AFTER_DRAIN) { E.fused(acc, cur, wr, wc, fr, fq, lds, wid, lane); S.done(cur); }
#undef PG8_SA
#undef PG8_SB
#undef PG8_STAGE
#undef PG8_LDA
#undef PG8_LDB
#undef PG8_MMA
#undef PG8_WAIT_V
#undef PG8_WAIT_L
#undef PG8_BAR
#undef PG8_SCHED
}
}

typedef unsigned short bf16;
typedef float f32x4 __attribute__((ext_vector_type(4)));
typedef unsigned u32x4 __attribute__((ext_vector_type(4)));
typedef unsigned u32x2 __attribute__((ext_vector_type(2)));
#define LAS __attribute__((address_space(3)))
__device__ __forceinline__ float bf2f(unsigned short v) { return __uint_as_float((unsigned)v << 16); }
__device__ __forceinline__ unsigned f2bf(float f) { unsigned u = __float_as_uint(f); return (u + 0x7fffu + ((u >> 16) & 1u)) >> 16; }
__device__ __forceinline__ unsigned pk2(float lo, float hi) { return f2bf(lo) | (f2bf(hi) << 16); }
__device__ __forceinline__ float wave_sum(float v) {
#pragma unroll
    for (int o = 1; o < 64; o <<= 1) v += __shfl_xor(v, o);
    return v;
}
__device__ __forceinline__ int rel_bucket(int dist) {
    int n = dist < 0 ? 0 : dist;
    if (n < 16) return n;
    int large = 16 + (int)(logf((float)n / 16.0f) / logf(8.0f) * 16.0f);
    return large > 31 ? 31 : large;
}

__device__ __forceinline__ u32x4 pack8(const f32x4 v0, const f32x4 v1) { u32x4 w; w.x = pg8::cvt_pk_bf16(v0[0], v0[1]); w.y = pg8::cvt_pk_bf16(v0[2], v0[3]); w.z = pg8::cvt_pk_bf16(v1[0], v1[1]); w.w = pg8::cvt_pk_bf16(v1[2], v1[3]); return w; }

struct EpiNsaIn {
    static constexpr bool PERM = true, AFTER_DRAIN = false;
    bf16* Q; bf16* KV; float* GATE; LAS const float* rsl; mutable int ui;
    __device__ __forceinline__ void operator()(const f32x4 (&acc)[2][2][4][2], const pg8::Unit& u, int wr, int wc, int fr, int fq) const {
        const int row0 = u.pm * 256 + wr * 64 + fr, colt = u.pn * 256 + wc * 32 + 8 * fq;
#pragma unroll
        for (int ai = 0; ai < 2; ++ai)
#pragma unroll
            for (int m = 0; m < 4; ++m) { const int row = row0 + ai * 128 + m * 16; const float rs = rsl[ui * 256 + wr * 64 + fr + ai * 128 + m * 16];
#pragma unroll
                for (int bj = 0; bj < 2; ++bj) { const int col = colt + bj * 128;
                    f32x4 v0 = acc[ai][bj][m][0] * rs, v1 = acc[ai][bj][m][1] * rs;
                    if (col < 1024) { v0 = v0 * C2; v1 = v1 * C2; *(u32x4*)(Q + (size_t)row * D + col) = pack8(v0, v1); }
                    else { *(u32x4*)(KV + (size_t)row * KVW + (col - 1024)) = pack8(v0, v1); }
                } }
        ++ui;
    }
};
struct EpiFoxIn {
    static constexpr bool PERM = true, AFTER_DRAIN = false;
    bf16* Q; bf16* KV; float* LF; LAS const float* rsl; const float* b_f; mutable int ui;
    __device__ __forceinline__ void operator()(const f32x4 (&acc)[2][2][4][2], const pg8::Unit& u, int wr, int wc, int fr, int fq) const {
        const int row0 = u.pm * 256 + wr * 64 + fr, colt = u.pn * 256 + wc * 32 + 8 * fq;
#pragma unroll
        for (int ai = 0; ai < 2; ++ai)
#pragma unroll
            for (int m = 0; m < 4; ++m) { const int row = row0 + ai * 128 + m * 16; const float rs = rsl[ui * 256 + wr * 64 + fr + ai * 128 + m * 16];
#pragma unroll
                for (int bj = 0; bj < 2; ++bj) { const int col = colt + bj * 128;
                    f32x4 v0 = acc[ai][bj][m][0] * rs, v1 = acc[ai][bj][m][1] * rs;
                    if (col < 1024) { v0 = v0 * C2; v1 = v1 * C2; *(u32x4*)(Q + (size_t)row * D + col) = pack8(v0, v1); }
                    else { *(u32x4*)(KV + (size_t)row * FKVW + (col - 1024)) = pack8(v0, v1); }
                } }
        ++ui;
    }
};
struct EpiRelu2 {
    static constexpr bool PERM = true, AFTER_DRAIN = false;
    bf16* Hh; LAS const float* rsl; mutable int ui;
    __device__ __forceinline__ void operator()(const f32x4 (&acc)[2][2][4][2], const pg8::Unit& u, int wr, int wc, int fr, int fq) const {
        const int row0 = u.pm * 256 + wr * 64 + fr, colt = u.pn * 256 + wc * 32 + 8 * fq;
#pragma unroll
        for (int ai = 0; ai < 2; ++ai)
#pragma unroll
            for (int m = 0; m < 4; ++m) { const int row = row0 + ai * 128 + m * 16; const float rs = rsl[ui * 256 + wr * 64 + fr + ai * 128 + m * 16];
#pragma unroll
                for (int bj = 0; bj < 2; ++bj) { const int col = colt + bj * 128;
                    f32x4 v0 = acc[ai][bj][m][0] * rs, v1 = acc[ai][bj][m][1] * rs;
#pragma unroll
                    for (int e = 0; e < 4; ++e) { const float a = fmaxf(v0[e], 0.f), b = fmaxf(v1[e], 0.f); v0[e] = a * a; v1[e] = b * b; }
                    *(u32x4*)(Hh + (size_t)row * DFF + col) = pack8(v0, v1); } }
        ++ui;
    }
};
template <bool IN_F32> struct EpiResid {
    static constexpr bool PERM = true, AFTER_DRAIN = false;
    const float* Xin; bf16* XB; float* SSP;
    __device__ __forceinline__ void operator()(const f32x4 (&acc)[2][2][4][2], const pg8::Unit& u, int wr, int wc, int fr, int fq) const {
        const int row0 = u.pm * 256 + wr * 64 + fr, colt = u.pn * 256 + wc * 32 + 8 * fq;
#pragma unroll
        for (int ai = 0; ai < 2; ++ai) {
            u32x4 rb[4][2]; f32x4 rx[4][2][2];
            if (IN_F32) {
#pragma unroll
                for (int m = 0; m < 4; ++m)
#pragma unroll
                    for (int bj = 0; bj < 2; ++bj) { const size_t off = (size_t)(row0 + ai * 128 + m * 16) * D + colt + bj * 128; rx[m][bj][0] = *(const f32x4*)(Xin + off); rx[m][bj][1] = *(const f32x4*)(Xin + off + 4); }
            } else {
#pragma unroll
                for (int m = 0; m < 4; ++m)
#pragma unroll
                    for (int bj = 0; bj < 2; ++bj) rb[m][bj] = *(const u32x4*)(XB + (size_t)(row0 + ai * 128 + m * 16) * D + colt + bj * 128);
            }
#pragma unroll
            for (int m = 0; m < 4; ++m) { const int row = row0 + ai * 128 + m * 16; float ssq = 0.f;
#pragma unroll
                for (int bj = 0; bj < 2; ++bj) { const size_t off = (size_t)row * D + colt + bj * 128;
                    f32x4 x0, x1;
                    if (IN_F32) { x0 = rx[m][bj][0]; x1 = rx[m][bj][1]; }
                    else { const u32x4 r4 = rb[m][bj];
                        x0[0] = __uint_as_float(r4.x << 16); x0[1] = __uint_as_float(r4.x & 0xffff0000u); x0[2] = __uint_as_float(r4.y << 16); x0[3] = __uint_as_float(r4.y & 0xffff0000u);
                        x1[0] = __uint_as_float(r4.z << 16); x1[1] = __uint_as_float(r4.z & 0xffff0000u); x1[2] = __uint_as_float(r4.w << 16); x1[3] = __uint_as_float(r4.w & 0xffff0000u); }
                    x0 = x0 + acc[ai][bj][m][0]; x1 = x1 + acc[ai][bj][m][1];
                    *(u32x4*)(XB + off) = pack8(x0, x1);
                    ssq += ((x0[0] * x0[0] + x0[1] * x0[1]) + (x0[2] * x0[2] + x0[3] * x0[3])) + ((x1[0] * x1[0] + x1[1] * x1[1]) + (x1[2] * x1[2] + x1[3] * x1[3])); }
                ssq += __shfl_xor(ssq, 16); ssq += __shfl_xor(ssq, 32);
                if (fq == 0) SSP[(size_t)row * 16 + u.pn * 4 + wc] = ssq; }
        }
    }
};

template <bool FRAG = false>
__device__ __forceinline__ void transpose_item(const float* W, const float* gain, int K, int N, bf16* WT, LAS float* scr, int item, int nblk, int lane) {
    const int kb = item / nblk, nb = item % nblk, k0 = 64 * kb, n0 = 32 * nb;
    const int nq = n0 + 4 * (lane & 7);
    f32x4 v[8];
    const bool inr = nq < N; const int nqc = inr ? nq : 0;
#pragma unroll
    for (int i = 0; i < 8; ++i) { const int kk = 8 * i + (lane >> 3); v[i] = __builtin_nontemporal_load((const f32x4*)(W + (size_t)(k0 + kk) * N + nqc)); }
    if (gain) {
        float gv[8];
#pragma unroll
        for (int i = 0; i < 8; ++i) gv[i] = gain[k0 + 8 * i + (lane >> 3)];
#pragma unroll
        for (int i = 0; i < 8; ++i) v[i] = v[i] * gv[i]; }
    if (!inr) {
#pragma unroll
        for (int i = 0; i < 8; ++i) v[i] = (f32x4){0.f, 0.f, 0.f, 0.f}; }
#pragma unroll
    for (int i = 0; i < 8; ++i) { const int kk = 8 * i + (lane >> 3); LAS float* sp = scr + kk * 33 + 4 * (lane & 7);
        sp[0] = v[i][0]; sp[1] = v[i][1]; sp[2] = v[i][2]; sp[3] = v[i][3]; }
    asm volatile("s_waitcnt lgkmcnt(0)" ::: "memory");
    const int c = lane & 7;
#pragma unroll
    for (int j = 0; j < 4; ++j) { const int n = (lane >> 3) + 8 * j; const LAS float* s = scr + (8 * c) * 33 + n;
        u32x4 o; o.x = pk2(s[0 * 33], s[1 * 33]); o.y = pk2(s[2 * 33], s[3 * 33]); o.z = pk2(s[4 * 33], s[5 * 33]); o.w = pk2(s[6 * 33], s[7 * 33]);
        if (FRAG) *(u32x4*)(WT + (size_t)((k0 >> 4) + (c >> 1)) * 1024 + (n0 + n) * 16 + 8 * (c & 1)) = o;
        else *(u32x4*)(WT + (size_t)(n0 + n) * K + k0 + 8 * c) = o; }
    asm volatile("s_waitcnt lgkmcnt(0)" ::: "memory");
}
__device__ __forceinline__ void xrow4_item(const float* x, bf16* XB, float* SSP, int row0, int lane) {
    f32x4 v[4][4]; float s[4];
#pragma unroll
    for (int r = 0; r < 4; ++r) { const f32x4* xr = (const f32x4*)(x + (size_t)(row0 + r) * D) + 2 * lane;
#pragma unroll
        for (int j = 0; j < 2; ++j) { v[r][2 * j] = __builtin_nontemporal_load(xr + 128 * j); v[r][2 * j + 1] = __builtin_nontemporal_load(xr + 128 * j + 1); } }
#pragma unroll
    for (int r = 0; r < 4; ++r) { float a = 0.f;
#pragma unroll
        for (int j = 0; j < 4; ++j) a += (v[r][j][0] * v[r][j][0] + v[r][j][1] * v[r][j][1]) + (v[r][j][2] * v[r][j][2] + v[r][j][3] * v[r][j][3]);
        s[r] = a; }
#pragma unroll
    for (int o = 1; o < 64; o <<= 1) {
#pragma unroll
        for (int r = 0; r < 4; ++r) s[r] += __shfl_xor(s[r], o); }
#pragma unroll
    for (int r = 0; r < 4; ++r) { u32x4* o16 = (u32x4*)(XB + (size_t)(row0 + r) * D) + lane;
#pragma unroll
        for (int j = 0; j < 2; ++j) { u32x4 w; w.x = pk2(v[r][2 * j][0], v[r][2 * j][1]); w.y = pk2(v[r][2 * j][2], v[r][2 * j][3]); w.z = pk2(v[r][2 * j + 1][0], v[r][2 * j + 1][1]); w.w = pk2(v[r][2 * j + 1][2], v[r][2 * j + 1][3]); o16[64 * j] = w; } }
    const int r = lane >> 4, sl = lane & 15;
    const float sv = (r == 0) ? s[0] : (r == 1) ? s[1] : (r == 2) ? s[2] : s[3];
    SSP[(size_t)(row0 + r) * 16 + sl] = (sl == 0) ? sv : 0.f;
}

template <class Sched> __device__ __forceinline__ void rstd_prepare(LAS float* rsl, const float* SSP, const Sched& So) {
    const int tid = threadIdx.x, r = tid >> 1, half = tid & 1;
    pg8::Unit u;
    for (int i = 0; So.next(i, u); ++i) {
        const f32x4* sp = (const f32x4*)(SSP + (size_t)(u.pm * 256 + r) * 16 + half * 8);
        const f32x4 a = sp[0], c = sp[1];
        float ss = ((a[0] + a[1]) + (a[2] + a[3])) + ((c[0] + c[1]) + (c[2] + c[3]));
        ss += __shfl_xor(ss, 1);
        if (half == 0) rsl[i * 256 + r] = rsqrtf(ss * (1.0f / D) + RMS_EPS);
    }
    __syncthreads();
}

typedef short sk_bf16x8 __attribute__((ext_vector_type(8)));
template <int MODE> __device__ __forceinline__ void skinny_cols(LAS unsigned char* lds, const bf16* XB, const bf16* W, const float* SSP, const float* b_f, float* out, int gw, int NGW, int lane) {
    constexpr int NCB = (MODE == 0) ? 3 : 1, NOUT = (MODE == 0) ? 48 : 16;
    const int r16 = lane & 15, kg = lane >> 4;
    {   const int wv = __builtin_amdgcn_readfirstlane((int)threadIdx.x >> 6);
#pragma unroll
        for (int i = 0; i < NOUT / 4; ++i) { const int q = (int)threadIdx.x + 512 * i, c = q >> 7, pslot = q & 127;
            __builtin_amdgcn_global_load_lds((const unsigned*)(W + (size_t)c * D + (pslot ^ (c & 15)) * 8), (LAS unsigned*)(lds + (wv * 64 + 512 * i) * 16), 16, 0, 0); }
    }
    bool first = true;
#pragma unroll 1
    for (int task = gw; task < M / 16; task += NGW) {
        const int row0 = task * 16;
        sk_bf16x8 af[32];
        {   const bf16* ap = XB + (size_t)(row0 + r16) * D + 8 * kg;
#pragma unroll
            for (int s_ = 0; s_ < 32; ++s_) af[s_] = *(const sk_bf16x8*)(ap + 32 * s_); }
        if (first) { asm volatile("s_waitcnt vmcnt(0)" ::: "memory"); __syncthreads(); first = false; }
        f32x4 acc[NCB];
#pragma unroll
        for (int cb = 0; cb < NCB; ++cb) acc[cb] = (f32x4){0.f, 0.f, 0.f, 0.f};
#pragma unroll
        for (int s_ = 0; s_ < 32; ++s_) {
#pragma unroll
            for (int cb = 0; cb < NCB; ++cb) { const sk_bf16x8 bf = *(LAS const sk_bf16x8*)(lds + (cb * 16 + r16) * 2048 + (((4 * s_ + kg) ^ r16) * 16));
                acc[cb] = __builtin_amdgcn_mfma_f32_16x16x32_bf16(af[s_], bf, acc[cb], 0, 0, 0); }
            if ((s_ & 3) == 3) __builtin_amdgcn_sched_barrier(0);
        }
        const f32x4* sp = (const f32x4*)(SSP + (size_t)(row0 + r16) * 16);
        const f32x4 sa = sp[0], sb = sp[1], sc = sp[2], sd = sp[3];
        const float ss = (((sa[0] + sa[1]) + (sa[2] + sa[3])) + ((sb[0] + sb[1]) + (sb[2] + sb[3]))) + (((sc[0] + sc[1]) + (sc[2] + sc[3])) + ((sd[0] + sd[1]) + (sd[2] + sd[3])));
        const float rstd = rsqrtf(ss * (1.0f / D) + RMS_EPS);
        float bfc[NCB];
#pragma unroll
        for (int cb = 0; cb < NCB; ++cb) bfc[cb] = (MODE == 1) ? b_f[cb * 16 + r16] : 0.f;
#pragma unroll
        for (int r = 0; r < 4; ++r) { const int rr = 4 * kg + r; const float rs = __shfl(rstd, rr);
#pragma unroll
            for (int cb = 0; cb < NCB; ++cb) { const int col = cb * 16 + r16; const float v = acc[cb][r] * rs;
                if (MODE == 0) out[(size_t)(row0 + rr) * NOUT + col] = 1.0f / (1.0f + __expf(-v));
                else { const float x = v + bfc[cb]; out[(size_t)(row0 + rr) * NOUT + col] = fminf(x, 0.f) - log1pf(__expf(-fabsf(x))); } } }
    }
    if (first) { asm volatile("s_waitcnt vmcnt(0)" ::: "memory"); __syncthreads(); }
}

struct EpiFinal {
    static constexpr bool PERM = true, AFTER_DRAIN = true;
    const bf16* XB; float* out; const float* gfin; unsigned* xbuf; unsigned* cnt;
    __device__ __forceinline__ void fused(f32x4 (&acc)[2][2][4][2], const pg8::Unit& u, int wr, int wc, int fr, int fq, PG8_LAS unsigned char* lds, int wid, int lane) const {
        PG8_LAS float* P = (PG8_LAS float*)lds;
        PG8_LAS float* Sr = (PG8_LAS float*)(lds + 4096);
        const int colt = u.pn * 256 + wc * 32 + 8 * fq;
        u32x4 rb[2][4][2];
#pragma unroll
        for (int ai = 0; ai < 2; ++ai)
#pragma unroll
            for (int m = 0; m < 4; ++m)
#pragma unroll
                for (int bj = 0; bj < 2; ++bj) rb[ai][m][bj] = *(const u32x4*)(XB + (size_t)(u.pm * 256 + ai * 128 + wr * 64 + m * 16 + fr) * D + colt + bj * 128);
#pragma unroll
        for (int ai = 0; ai < 2; ++ai)
#pragma unroll
            for (int m = 0; m < 4; ++m) { const int rl = ai * 128 + wr * 64 + m * 16 + fr; float ssq = 0.f;
#pragma unroll
                for (int bj = 0; bj < 2; ++bj) { const u32x4 r4 = rb[ai][m][bj];
                    f32x4 x0 = acc[ai][bj][m][0], x1 = acc[ai][bj][m][1];
                    x0[0] += __uint_as_float(r4.x << 16); x0[1] += __uint_as_float(r4.x & 0xffff0000u); x0[2] += __uint_as_float(r4.y << 16); x0[3] += __uint_as_float(r4.y & 0xffff0000u);
                    x1[0] += __uint_as_float(r4.z << 16); x1[1] += __uint_as_float(r4.z & 0xffff0000u); x1[2] += __uint_as_float(r4.w << 16); x1[3] += __uint_as_float(r4.w & 0xffff0000u);
                    acc[ai][bj][m][0] = x0; acc[ai][bj][m][1] = x1;
                    ssq += ((x0[0] * x0[0] + x0[1] * x0[1]) + (x0[2] * x0[2] + x0[3] * x0[3])) + ((x1[0] * x1[0] + x1[1] * x1[1]) + (x1[2] * x1[2] + x1[3] * x1[3])); }
                ssq += __shfl_xor(ssq, 16); ssq += __shfl_xor(ssq, 32);
                if (fq == 0) P[rl * 4 + wc] = ssq; }
        asm volatile("s_waitcnt lgkmcnt(0)" ::: "memory"); __builtin_amdgcn_s_barrier(); asm volatile("" ::: "memory");
        const int t = wid * 64 + lane;
        if (wid < 4) {
            const f32x4 pv = *(PG8_LAS const f32x4*)(P + t * 4);
            const float tot = (pv[0] + pv[1]) + (pv[2] + pv[3]);
            __hip_atomic_store(xbuf + (size_t)(u.pm * 256 + t) * 4 + u.pn, __float_as_uint(tot), __ATOMIC_RELAXED, __HIP_MEMORY_SCOPE_AGENT);
            asm volatile("s_waitcnt vmcnt(0)" ::: "memory");
            if (lane == 0) __hip_atomic_fetch_add(cnt + 64 * u.pm, 1u, __ATOMIC_RELAXED, __HIP_MEMORY_SCOPE_AGENT);
        }
        if (wid == 0) {
            unsigned sp = 0;
            while ((unsigned)__builtin_amdgcn_readfirstlane(__hip_atomic_load(cnt + 64 * u.pm, __ATOMIC_RELAXED, __HIP_MEMORY_SCOPE_AGENT)) < 16u) { __builtin_amdgcn_s_sleep(2); if (++sp > (1u << 22)) break; }
            __builtin_amdgcn_fence(__ATOMIC_ACQUIRE, "agent");
        }
        asm volatile("s_waitcnt vmcnt(0) lgkmcnt(0)" ::: "memory"); __builtin_amdgcn_s_barrier(); asm volatile("" ::: "memory");
        if (wid < 4) {
            const unsigned* slot = xbuf + (size_t)(u.pm * 256 + t) * 4;
            const float s0 = __uint_as_float(__hip_atomic_load(slot + 0, __ATOMIC_RELAXED, __HIP_MEMORY_SCOPE_AGENT)), s1 = __uint_as_float(__hip_atomic_load(slot + 1, __ATOMIC_RELAXED, __HIP_MEMORY_SCOPE_AGENT));
            const float s2 = __uint_as_float(__hip_atomic_load(slot + 2, __ATOMIC_RELAXED, __HIP_MEMORY_SCOPE_AGENT)), s3 = __uint_as_float(__hip_atomic_load(slot + 3, __ATOMIC_RELAXED, __HIP_MEMORY_SCOPE_AGENT));
            Sr[t] = rsqrtf(((s0 + s1) + (s2 + s3)) * (1.0f / D) + RMS_EPS);
        }
        asm volatile("s_waitcnt lgkmcnt(0)" ::: "memory"); __builtin_amdgcn_s_barrier(); asm volatile("" ::: "memory");
        f32x4 gv[2][2];
#pragma unroll
        for (int bj = 0; bj < 2; ++bj)
#pragma unroll
            for (int n = 0; n < 2; ++n) gv[bj][n] = *(const f32x4*)(gfin + colt + bj * 128 + n * 4);
#pragma unroll
        for (int ai = 0; ai < 2; ++ai)
#pragma unroll
            for (int m = 0; m < 4; ++m) { const int rl = ai * 128 + wr * 64 + m * 16 + fr; const float rs = Sr[rl]; const size_t rowoff = (size_t)(u.pm * 256 + rl) * D;
#pragma unroll
                for (int bj = 0; bj < 2; ++bj)
#pragma unroll
                    for (int n = 0; n < 2; ++n) *(f32x4*)(out + rowoff + colt + bj * 128 + n * 4) = acc[ai][bj][m][n] * rs * gv[bj][n]; }
    }
};

namespace att {
__device__ __forceinline__ float sum8(float s) {
    s += __builtin_bit_cast(float, __builtin_amdgcn_update_dpp(0, __builtin_bit_cast(int, s), 0xB1, 0xf, 0xf, true));
    s += __builtin_bit_cast(float, __builtin_amdgcn_update_dpp(0, __builtin_bit_cast(int, s), 0x4E, 0xf, 0xf, true));
    s += __builtin_bit_cast(float, __builtin_amdgcn_update_dpp(0, __builtin_bit_cast(int, s), 0x141, 0xf, 0xf, true));
    return s;
}
typedef short bf16x8 __attribute__((ext_vector_type(8)));
typedef short s16x4 __attribute__((ext_vector_type(4)));
typedef float f32x16 __attribute__((ext_vector_type(16)));
typedef float f32x2_t __attribute__((ext_vector_type(2)));
typedef __bf16 bf16x2_t __attribute__((ext_vector_type(2)));
typedef short v4i16_t __attribute__((ext_vector_type(4)));
typedef LAS const unsigned char* lptr;
constexpr float NEG = -3.0e38f;
constexpr float THR = 8.0f;
#define WAIT_BAR() asm volatile("s_waitcnt vmcnt(0) lgkmcnt(0)\n\ts_barrier" ::: "memory")
#define LGKM0() asm volatile("s_waitcnt lgkmcnt(0)" ::: "memory")
__device__ __forceinline__ int crow(int r, int hi) { return (r & 3) + 8 * (r >> 2) + 4 * hi; }
__device__ __forceinline__ unsigned cvtpk(float lo, float hi) { f32x2_t v = {lo, hi}; bf16x2_t b = __builtin_convertvector(v, bf16x2_t); return __builtin_bit_cast(unsigned, b); }
__device__ __forceinline__ s16x4 vtr(lptr p) { return __builtin_bit_cast(s16x4, __builtin_amdgcn_ds_read_tr16_b64_v4i16((LAS v4i16_t*)p)); }
__device__ __forceinline__ float xhalf(float v) { const auto rr = __builtin_amdgcn_permlane32_swap(__float_as_uint(v), __float_as_uint(v), false, false); return __uint_as_float((threadIdx.x & 32) ? rr[0] : rr[1]); }

__device__ __forceinline__ void dma_kv(LAS unsigned char* kbuf, LAS unsigned char* vbuf, const bf16* Kg, const bf16* Vg, int pitch, int wave, int lane) {
    __builtin_amdgcn_global_load_lds((const unsigned*)(Kg + (size_t)lane * pitch + wave * 8), (LAS unsigned*)(kbuf + wave * 1024), 16, 0, 0);
    __builtin_amdgcn_global_load_lds((const unsigned*)(Vg + (size_t)(16 * (wave & 3) + (lane >> 2)) * pitch + (wave >> 2) * 32 + (lane & 3) * 8), (LAS unsigned*)(vbuf + wave * 1024), 16, 0, 0);
}
struct Acc { f32x16 o[2]; float m, l; };
__device__ __forceinline__ void acc_init(Acc& a) { a.m = -1.0e30f; a.l = 0.f;
#pragma unroll
    for (int r = 0; r < 16; ++r) { a.o[0][r] = 0.f; a.o[1][r] = 0.f; } }
__device__ __forceinline__ void qk(f32x16& p0, f32x16& p1, lptr kbuf, const bf16x8* qf, int r32, int hi) {
    lptr kb = kbuf + hi * 1024 + r32 * 16;
#pragma unroll
    for (int d0 = 0; d0 < 4; ++d0) {
        const bf16x8 b0 = *(LAS const bf16x8*)(kb + d0 * 2048);
        const bf16x8 b1 = *(LAS const bf16x8*)(kb + d0 * 2048 + 512);
        p0 = __builtin_amdgcn_mfma_f32_32x32x16_bf16(b0, qf[d0], p0, 0, 0, 0);
        p1 = __builtin_amdgcn_mfma_f32_32x32x16_bf16(b1, qf[d0], p1, 0, 0, 0);
    }
}
__device__ __forceinline__ void acc_merge(f32x16 (&res)[2], Acc& a, float gate, LAS float* wsf, int r32, int hi) {
    const float lt = a.l + xhalf(a.l);
    const float f = gate / fmaxf(lt, 1e-30f);
    LGKM0();
    if (hi == 0) wsf[r32] = f;
    LGKM0();
#pragma unroll
    for (int i = 0; i < 4; ++i) { const f32x4 fv = *(LAS const f32x4*)(wsf + 8 * i + 4 * hi);
#pragma unroll
        for (int e = 0; e < 4; ++e) { res[0][4 * i + e] += a.o[0][4 * i + e] * fv[e]; res[1][4 * i + e] += a.o[1][4 * i + e] * fv[e]; } }
    LGKM0();
}


constexpr int TLEN = 704;
__device__ __forceinline__ void gather_c(f32x16& p0, f32x16& p1, LAS const float* Tl) {
#pragma unroll
    for (int r = 0; r < 16; ++r) { const int ko = (r & 3) + 8 * (r >> 2); p0[r] = Tl[63 - ko]; p1[r] = Tl[31 - ko]; }
}
#define OPAQUE(x) asm volatile("" : "+v"(x))

__device__ __forceinline__ float gelu_tanh(float x) { float u = 0.7978845608028654f * (x + 0.044715f * x * x * x); u = fminf(fmaxf(u, -15.0f), 15.0f); const float e = __expf(2.0f * u); return 0.5f * x * (1.0f + (e - 1.0f) / (e + 1.0f)); }
__device__ __forceinline__ void compress_phase(LAS unsigned char* lds, const bf16* KV, const float* pe_k, const float* pe_v, const bf16* W1T, const float* wk2, const float* wv2, bf16* KC, bf16* VC) {
    const int tid = threadIdx.x, lane = tid & 63, wave = __builtin_amdgcn_readfirstlane(tid >> 6), r32 = lane & 31, hi = lane >> 5;
    LAS float* part = (LAS float*)lds;
    LAS float* hid = (LAS float*)(lds + 65536);
    LAS float* w2s = (LAS float*)(lds + 81920);
    LAS float* pes = (LAS float*)(lds + 98304);
    int staged = -1;
    for (int u = blockIdx.x; u < 64 * 2 * 4; u += gridDim.x) {
        const int cblk = u & 3, which = (u >> 2) & 1, bg = u >> 3, b = bg >> 2, g = bg & 3;
        if (which != staged) {
            __syncthreads();
            const float* w2g = which ? wv2 : wk2; const float* peg = which ? pe_v : pe_k;
            *(LAS f32x4*)(w2s + 4 * tid) = *(const f32x4*)(w2g + 4 * tid); *(LAS f32x4*)(w2s + 2048 + 4 * tid) = *(const f32x4*)(w2g + 2048 + 4 * tid);
            *(LAS f32x4*)(pes + 4 * tid) = *(const f32x4*)(peg + 4 * tid);
            __syncthreads(); staged = which;
        }
        const bf16* w1t = W1T + (size_t)which * 64 * 2048;
        bf16* out = which ? VC : KC;
        f32x16 acc0, acc1;
#pragma unroll
        for (int r = 0; r < 16; ++r) { acc0[r] = 0.f; acc1[r] = 0.f; }
        bf16x8 b0[8], b1[8];
#pragma unroll
        for (int q = 0; q < 8; ++q) { const int k0 = 256 * wave + 16 * q;
            b0[q] = *(const bf16x8*)(w1t + (size_t)(k0 >> 4) * 1024 + r32 * 16 + 8 * hi);
            b1[q] = *(const bf16x8*)(w1t + (size_t)(k0 >> 4) * 1024 + (r32 + 32) * 16 + 8 * hi); }
        __syncthreads();
        {   const bf16* src = KV + (size_t)b * S * KVW + which * 256 + g * 64;
            u32x4 st[9];
#pragma unroll
            for (int i = 0; i < 9; ++i) { const int q = tid + 512 * i, r = q >> 3, ch = q & 7; int tok = 512 * cblk + r; if (tok > S - 1) tok = S - 1;
                if (q < 528 * 8) st[i] = *(const u32x4*)(src + (size_t)tok * KVW + ch * 8); }
#pragma unroll
            for (int i = 0; i < 9; ++i) { const int q = tid + 512 * i, r = q >> 3, ch = q & 7;
                if (q < 528 * 8) *(LAS u32x4*)(lds + r * 128 + ((ch ^ ((r >> 4) & 7)) * 16)) = st[i]; }
        }
        __syncthreads();
#pragma unroll 1
        for (int h2 = 0; h2 < 2; ++h2) {
            if (h2 == 1) {
#pragma unroll
                for (int q = 0; q < 8; ++q) { const int k0 = 256 * wave + 16 * (8 + q);
                    b0[q] = *(const bf16x8*)(w1t + (size_t)(k0 >> 4) * 1024 + r32 * 16 + 8 * hi);
                    b1[q] = *(const bf16x8*)(w1t + (size_t)(k0 >> 4) * 1024 + (r32 + 32) * 16 + 8 * hi); } }
#pragma unroll
            for (int q = 0; q < 8; ++q) { const int k0 = 256 * wave + 16 * (8 * h2 + q), l = k0 >> 6, d = (k0 & 63) + 8 * hi, r = 16 * r32 + l;
                const u32x4 raw = *(LAS const u32x4*)(lds + r * 128 + (((d >> 3) ^ ((r >> 4) & 7)) * 16));
                const f32x4 pa_ = *(LAS const f32x4*)(pes + l * 64 + d), pb_ = *(LAS const f32x4*)(pes + l * 64 + d + 4);
                u32x4 w;
                w.x = cvtpk(__uint_as_float(raw.x << 16) + pa_[0], __uint_as_float(raw.x & 0xffff0000u) + pa_[1]);
                w.y = cvtpk(__uint_as_float(raw.y << 16) + pa_[2], __uint_as_float(raw.y & 0xffff0000u) + pa_[3]);
                w.z = cvtpk(__uint_as_float(raw.z << 16) + pb_[0], __uint_as_float(raw.z & 0xffff0000u) + pb_[1]);
                w.w = cvtpk(__uint_as_float(raw.w << 16) + pb_[2], __uint_as_float(raw.w & 0xffff0000u) + pb_[3]);
                const bf16x8 af = __builtin_bit_cast(bf16x8, w);
                acc0 = __builtin_amdgcn_mfma_f32_32x32x16_bf16(af, b0[q], acc0, 0, 0, 0);
                acc1 = __builtin_amdgcn_mfma_f32_32x32x16_bf16(af, b1[q], acc1, 0, 0, 0); }
        }
        __syncthreads();
#pragma unroll
        for (int r = 0; r < 16; ++r) { LAS float* pp = part + wave * 2048 + crow(r, hi) * 64 + r32; pp[0] = acc0[r]; pp[32] = acc1[r]; }
        __syncthreads();
        const int cr = tid >> 4, n4 = (tid & 15) * 4;
        {   f32x4 sum = *(LAS const f32x4*)(part + cr * 64 + n4);
#pragma unroll
            for (int w = 1; w < 8; ++w) sum = sum + *(LAS const f32x4*)(part + w * 2048 + cr * 64 + n4);
            f32x4 hv; hv[0] = gelu_tanh(sum[0]); hv[1] = gelu_tanh(sum[1]); hv[2] = gelu_tanh(sum[2]); hv[3] = gelu_tanh(sum[3]);
            *(LAS f32x4*)(hid + cr * 64 + n4) = hv; }
        __syncthreads();
        f32x4 o = {0.f, 0.f, 0.f, 0.f};
#pragma unroll 8
        for (int i = 0; i < 64; ++i) { const float hvv = hid[cr * 64 + i]; const f32x4 wv = *(LAS const f32x4*)(w2s + i * 64 + n4); o = o + hvv * wv; }
        const int cg_ = cblk * 32 + cr;
        if (cg_ >= NC) o = (f32x4){0.f, 0.f, 0.f, 0.f};
        u32x2 pk; pk.x = cvtpk(o[0], o[1]); pk.y = cvtpk(o[2], o[3]);
        *(u32x2*)(out + ((size_t)bg * 128 + cg_) * 64 + n4) = pk;
    }
}
#undef OPAQUE
#undef WAIT_BAR
#undef LGKM0
}

namespace att {
#define WAIT_BAR() asm volatile("s_waitcnt vmcnt(0) lgkmcnt(0)\n\ts_barrier" ::: "memory")
#define LGKM0() asm volatile("s_waitcnt lgkmcnt(0)" ::: "memory")

#undef WAIT_BAR
#undef LGKM0
}

namespace att {
#define LGKM0() asm volatile("s_waitcnt lgkmcnt(0)" ::: "memory")
template <bool MASKROWS>
__device__ __forceinline__ void exp_pack(float& lsum, f32x16& c0, f32x16& c1, bf16x8 (&pa)[4], bool okc) {
    float s0 = 0.f, s1 = 0.f;
#pragma unroll
    for (int r = 0; r < 16; ++r) { c0[r] = __builtin_amdgcn_exp2f(c0[r]); c1[r] = __builtin_amdgcn_exp2f(c1[r]); s0 += c0[r]; s1 += c1[r]; }
    const unsigned km = (MASKROWS && !okc) ? 0u : 0xffffffffu;
#pragma unroll
    for (int s = 0; s < 2; ++s) {
        u32x4 w0, w1;
        w0.x = cvtpk(c0[8 * s + 0], c0[8 * s + 1]); w0.y = cvtpk(c0[8 * s + 2], c0[8 * s + 3]); w0.z = cvtpk(c0[8 * s + 4], c0[8 * s + 5]); w0.w = cvtpk(c0[8 * s + 6], c0[8 * s + 7]);
        w1.x = cvtpk(c1[8 * s + 0], c1[8 * s + 1]); w1.y = cvtpk(c1[8 * s + 2], c1[8 * s + 3]); w1.z = cvtpk(c1[8 * s + 4], c1[8 * s + 5]); w1.w = cvtpk(c1[8 * s + 6], c1[8 * s + 7]);
        if (MASKROWS) { w0 = w0 & km; w1 = w1 & km; }
        pa[s] = __builtin_bit_cast(bf16x8, w0); pa[2 + s] = __builtin_bit_cast(bf16x8, w1);
    }
    const float st = s0 + s1;
    lsum += (MASKROWS && !okc) ? 0.f : st;
}
__device__ __forceinline__ float qnorm32(const bf16x8* qf) {
    float s = 0.f;
#pragma unroll
    for (int d0 = 0; d0 < 4; ++d0)
#pragma unroll
        for (int j = 0; j < 8; ++j) { const float v = bf2f((unsigned short)qf[d0][j]); s += v * v; }
    s += xhalf(s);
    return sqrtf(s);
}

#undef LGKM0
}

namespace att {
__device__ __forceinline__ void glds16s(unsigned voff, const void* sbase, unsigned lds_dst) { unsigned keep;
    asm volatile("s_mov_b32 %0, m0\n\ts_mov_b32 m0, %3\n\ts_nop 0\n\tglobal_load_lds_dwordx4 %1, %2\n\ts_mov_b32 m0, %0" : "=&s"(keep) : "v"(voff), "s"(sbase), "s"(lds_dst) : "memory"); }
__device__ __forceinline__ const bf16* uni(const bf16* p) {
    const unsigned long long v = (unsigned long long)p;
    const unsigned lo = __builtin_amdgcn_readfirstlane((unsigned)v), hi = __builtin_amdgcn_readfirstlane((unsigned)(v >> 32));
    return (const bf16*)(((unsigned long long)hi << 32) | lo);
}
__device__ __forceinline__ void qk4z(f32x16& p0, f32x16& p1, const unsigned (&ka)[4], const bf16x8* qf) {
    const f32x16 z = {0.f, 0.f, 0.f, 0.f, 0.f, 0.f, 0.f, 0.f, 0.f, 0.f, 0.f, 0.f, 0.f, 0.f, 0.f, 0.f};
    {   const bf16x8 b0 = *(LAS const bf16x8*)(uintptr_t)ka[0], b1 = *(LAS const bf16x8*)(uintptr_t)(ka[0] + 4096);
        p0 = __builtin_amdgcn_mfma_f32_32x32x16_bf16(b0, qf[0], z, 0, 0, 0);
        p1 = __builtin_amdgcn_mfma_f32_32x32x16_bf16(b1, qf[0], z, 0, 0, 0); }
#pragma unroll
    for (int d0 = 1; d0 < 4; ++d0) {
        const bf16x8 b0 = *(LAS const bf16x8*)(uintptr_t)ka[d0], b1 = *(LAS const bf16x8*)(uintptr_t)(ka[d0] + 4096);
        p0 = __builtin_amdgcn_mfma_f32_32x32x16_bf16(b0, qf[d0], p0, 0, 0, 0);
        p1 = __builtin_amdgcn_mfma_f32_32x32x16_bf16(b1, qf[d0], p1, 0, 0, 0);
    }
}
__device__ __forceinline__ void qk4c(f32x16& p0, f32x16& p1, const f32x16& ci0, const f32x16& ci1, const unsigned (&ka)[4], const bf16x8* qf) {
    {   const bf16x8 b0 = *(LAS const bf16x8*)(uintptr_t)ka[0], b1 = *(LAS const bf16x8*)(uintptr_t)(ka[0] + 4096);
        p0 = __builtin_amdgcn_mfma_f32_32x32x16_bf16(b0, qf[0], ci0, 0, 0, 0);
        p1 = __builtin_amdgcn_mfma_f32_32x32x16_bf16(b1, qf[0], ci1, 0, 0, 0); }
#pragma unroll
    for (int d0 = 1; d0 < 4; ++d0) {
        const bf16x8 b0 = *(LAS const bf16x8*)(uintptr_t)ka[d0], b1 = *(LAS const bf16x8*)(uintptr_t)(ka[d0] + 4096);
        p0 = __builtin_amdgcn_mfma_f32_32x32x16_bf16(b0, qf[d0], p0, 0, 0, 0);
        p1 = __builtin_amdgcn_mfma_f32_32x32x16_bf16(b1, qf[d0], p1, 0, 0, 0);
    }
}
__device__ __forceinline__ void pv4_load(bf16x8 (&vf)[8], unsigned va) {
#pragma unroll
    for (int d0 = 0; d0 < 2; ++d0)
#pragma unroll
        for (int ks = 0; ks < 4; ++ks) {
            const s16x4 lo = vtr((lptr)(uintptr_t)(va + d0 * 4096 + ks * 1024)), hh = vtr((lptr)(uintptr_t)(va + d0 * 4096 + ks * 1024 + 512));
            vf[d0 * 4 + ks] = (bf16x8){lo[0], lo[1], lo[2], lo[3], hh[0], hh[1], hh[2], hh[3]}; }
}
__device__ __forceinline__ void pv4_mma(f32x16 (&o)[2], const bf16x8 (&pa)[4], const bf16x8 (&vf)[8]) {
#pragma unroll
    for (int d0 = 0; d0 < 2; ++d0)
#pragma unroll
        for (int ks = 0; ks < 4; ++ks) o[d0] = __builtin_amdgcn_mfma_f32_32x32x16_bf16(pa[ks], vf[d0 * 4 + ks], o[d0], 0, 0, 0);
}
__device__ __forceinline__ void pv4(f32x16 (&o)[2], const bf16x8 (&pa)[4], unsigned va) {
#pragma unroll
    for (int d0 = 0; d0 < 2; ++d0)
#pragma unroll
        for (int ks = 0; ks < 4; ++ks) {
            const s16x4 lo = vtr((lptr)(uintptr_t)(va + d0 * 4096 + ks * 1024)), hh = vtr((lptr)(uintptr_t)(va + d0 * 4096 + ks * 1024 + 512));
            const bf16x8 vf = (bf16x8){lo[0], lo[1], lo[2], lo[3], hh[0], hh[1], hh[2], hh[3]};
            o[d0] = __builtin_amdgcn_mfma_f32_32x32x16_bf16(pa[ks], vf, o[d0], 0, 0, 0);
        }
}


__device__ __forceinline__ void store_o_lds(const f32x16 (&res)[2], bf16* O, size_t row0, int col0, LAS unsigned short* stg, int lane, int r32, int hi) {
#pragma unroll
    for (int r = 0; r < 16; ++r) { const int orow = crow(r, hi);
        stg[orow * 64 + r32] = (unsigned short)f2bf(res[0][r]); stg[orow * 64 + 32 + r32] = (unsigned short)f2bf(res[1][r]); }
    asm volatile("s_waitcnt lgkmcnt(0)" ::: "memory");
#pragma unroll
    for (int i = 0; i < 4; ++i) { const int row = i * 8 + (lane >> 3), ch = lane & 7;
        const u32x4 v = *(LAS const u32x4*)(stg + row * 64 + ch * 8);
        *(u32x4*)(O + (row0 + row) * D + col0 + ch * 8) = v; }
    asm volatile("s_waitcnt lgkmcnt(0)" ::: "memory");
}
__device__ __forceinline__ void fox_phase4(LAS unsigned char* lds, const bf16* Q, const bf16* KV, const float* LF, bf16* O) {
    const int tid = threadIdx.x, wave = __builtin_amdgcn_readfirstlane(tid >> 6);
    const unsigned lds0 = (unsigned)(uintptr_t)lds;
    LAS unsigned char* KX = lds + 65536;
    LAS float* nc2 = (LAS float*)(lds + 98304);
    LAS float* wsf = (LAS float*)(lds + 106496) + wave * 64;
    LAS float* wt = (LAS float*)(lds + 108544);
    LAS float* wmx = wt + 16;
    for (int bh = blockIdx.x; bh < NB * NH; bh += gridDim.x) {
        const int b = bh >> 4, h = bh & 15;
        const size_t rowb = (size_t)b * S;
        const bf16* Kg = uni(KV + rowb * FKVW + h * 64); const bf16* Vg = Kg + 1024;
        float kmax;
        {   const int lane = tid & 63;
            float v[4]; float tot = 0.f, kn = 0.f;
#pragma unroll
            for (int i = 0; i < 4; ++i) { tot += LF[(rowb + 4 * tid + i) * 16 + h]; v[i] = tot;
                const u32x4* kr = (const u32x4*)(Kg + (size_t)(4 * tid + i) * FKVW); float s = 0.f;
#pragma unroll
                for (int c = 0; c < 8; ++c) { const u32x4 w = kr[c];
                    const float a0 = __uint_as_float(w.x << 16), a1 = __uint_as_float(w.x & 0xffff0000u), a2 = __uint_as_float(w.y << 16), a3 = __uint_as_float(w.y & 0xffff0000u);
                    const float a4 = __uint_as_float(w.z << 16), a5 = __uint_as_float(w.z & 0xffff0000u), a6 = __uint_as_float(w.w << 16), a7 = __uint_as_float(w.w & 0xffff0000u);
                    s += (a0 * a0 + a1 * a1) + (a2 * a2 + a3 * a3) + (a4 * a4 + a5 * a5) + (a6 * a6 + a7 * a7); }
                kn = fmaxf(kn, s); }
            float inc = tot;
#pragma unroll
            for (int o = 1; o < 64; o <<= 1) { const float n = __shfl_up(inc, o), n2 = __shfl_up(kn, o); if (lane >= o) { inc += n; kn = fmaxf(kn, n2); } }
            __syncthreads();
            if (lane == 63) { wt[wave] = inc; wmx[wave] = kn; }
            __syncthreads();
            float base = inc - tot;
            for (int w = 0; w < wave; ++w) base += wt[w];
            kn = wmx[0];
#pragma unroll
            for (int w = 1; w < 8; ++w) kn = fmaxf(kn, wmx[w]);
            kmax = sqrtf(kn);
#pragma unroll
            for (int i = 0; i < 4; ++i) { const float x = -(base + v[i]) * LOG2E; nc2[4 * tid + i] = x;
                const unsigned hb = f2bf(x); const float r1 = x - __uint_as_float(hb << 16);
                const unsigned lb = f2bf(r1); const float r2 = r1 - __uint_as_float(lb << 16);
                const unsigned llb = f2bf(r2);
                u32x4 e; e.x = hb | (lb << 16); e.y = llb | 0x3f800000u; e.z = 0u; e.w = 0u;
                *(LAS u32x4*)(KX + (size_t)(4 * tid + i) * 16) = e; }
            __syncthreads();
        }
#pragma unroll 1
        for (int qb = 7; qb >= 0; --qb) {
            int lnu_ = tid & 63; asm volatile("" : "+v"(lnu_));
            const int lane = lnu_, r32 = lnu_ & 31, hi = lnu_ >> 5;
            const int q0 = 256 * qb + 32 * wave, qpos = q0 + r32, NT = 4 * qb + 4;
            const int nact = (q0 + 31) / 64 + 1;
            bf16x8 qf[4];
#pragma unroll
            for (int d0 = 0; d0 < 4; ++d0) qf[d0] = *(const bf16x8*)(Q + (rowb + qpos) * D + h * 64 + d0 * 16 + hi * 8);
            const float mrow = qnorm32(qf) * kmax + nc2[qpos];
            const unsigned mbb = f2bf(mrow * 1.01f + 1.0f);
            u32x4 qxw; qxw.x = hi ? 0u : 0x3f803f80u; qxw.y = hi ? 0u : (0x00003f80u | ((mbb ^ 0x8000u) << 16)); qxw.z = 0u; qxw.w = 0u;
            const bf16x8 qx = __builtin_bit_cast(bf16x8, qxw);
            unsigned kofs[4];
#pragma unroll
            for (int d0 = 0; d0 < 4; ++d0) kofs[d0] = lds0 + r32 * 128 + (((2 * d0 + hi) ^ ((r32 >> 1) & 7)) << 4);
            const unsigned vbo = lds0 + 32768 + ((lane >> 4) & 1) * 32 + (lane & 3) * 8 + (4 * hi + ((lane & 15) >> 2)) * 64;
            const unsigned kxo = lds0 + 65536 + r32 * 16;
            const int krow = 8 * wave + (lane >> 3);
            const unsigned kdma = (unsigned)krow * (FKVW * 2) + (((lane & 7) ^ ((krow >> 1) & 7)) << 4);
            const unsigned vdma = (unsigned)(16 * (wave & 3) + (lane >> 2)) * (FKVW * 2) + (wave >> 2) * 64 + (lane & 3) * 16;
            const unsigned kdst = lds0 + wave * 1024, vdst = lds0 + 32768 + wave * 1024;
            Acc a; acc_init(a);
#define FOX_DMA_K(t) glds16s(kdma, Kg + (size_t)(t) * 64 * FKVW, (unsigned)__builtin_amdgcn_readfirstlane(kdst + ((t) & 3) * 8192))
#define FOX_DMA_V(t) glds16s(vdma, Vg + (size_t)(t) * 64 * FKVW, (unsigned)__builtin_amdgcn_readfirstlane(vdst + ((t) & 3) * 8192))
            if (qb == 7) {
                asm volatile("s_waitcnt vmcnt(0) lgkmcnt(0)\n\ts_barrier" ::: "memory");
                FOX_DMA_K(0); FOX_DMA_V(0); FOX_DMA_K(1); FOX_DMA_K(2); FOX_DMA_V(1);
            }
            asm volatile("s_waitcnt vmcnt(0) lgkmcnt(0)\n\ts_barrier" ::: "memory");
#define FOX_BIAS(P0, P1, t) do { const unsigned kxa = kxo + (unsigned)(t) * 1024u; \
                const bf16x8 x0 = *(LAS const bf16x8*)(uintptr_t)kxa, x1 = *(LAS const bf16x8*)(uintptr_t)(kxa + 512); \
                P0 = __builtin_amdgcn_mfma_f32_32x32x16_bf16(x0, qx, P0, 0, 0, 0); P1 = __builtin_amdgcn_mfma_f32_32x32x16_bf16(x1, qx, P1, 0, 0, 0); } while (0)
#define FOX_KA(t) unsigned ka[4]; { const unsigned so = (unsigned)((t) & 3) * 8192u; ka[0] = kofs[0] + so; ka[1] = kofs[1] + so; ka[2] = kofs[2] + so; ka[3] = kofs[3] + so; }
#define FOX_SCORES_Z(P0, P1, t) do { FOX_KA(t) qk4z(P0, P1, ka, qf); FOX_BIAS(P0, P1, t); } while (0)
#define FOX_SCORES_D(P0, P1, t) do { const int k0_ = 64 * (t); f32x16 ci0, ci1; \
                _Pragma("unroll") for (int r = 0; r < 16; ++r) { const int key = k0_ + crow(r, hi); ci0[r] = (key > qpos) ? NEG : 0.f; ci1[r] = (key + 32 > qpos) ? NEG : 0.f; } \
                FOX_KA(t) qk4c(P0, P1, ci0, ci1, ka, qf); FOX_BIAS(P0, P1, t); } while (0)
            f32x16 sA0, sA1, sB0, sB1;
            if (nact == 1) FOX_SCORES_D(sA0, sA1, 0); else FOX_SCORES_Z(sA0, sA1, 0);
#define FOX_PREFIX(j) \
            if ((j) + 2 < NT) asm volatile("s_waitcnt vmcnt(2) lgkmcnt(0)\n\ts_barrier" ::: "memory"); \
            else if ((j) + 1 < NT) asm volatile("s_waitcnt vmcnt(1) lgkmcnt(0)\n\ts_barrier" ::: "memory"); \
            else asm volatile("s_waitcnt vmcnt(0) lgkmcnt(0)\n\ts_barrier" ::: "memory");     \
            if ((j) + 3 < NT) FOX_DMA_K((j) + 3); \
            if ((j) + 2 < NT) FOX_DMA_V((j) + 2);
#define FOX_FULLZ(C0, C1, N0, N1, j) do { FOX_PREFIX(j) bf16x8 pa[4]; \
                FOX_SCORES_Z(N0, N1, (j) + 1);       \
                exp_pack<false>(a.l, C0, C1, pa, true); \
                pv4(a.o, pa, vbo + (unsigned)((j) & 3) * 8192u); } while (0)
#define FOX_FULLD(C0, C1, N0, N1, j) do { FOX_PREFIX(j) bf16x8 pa[4]; \
                FOX_SCORES_D(N0, N1, (j) + 1); \
                exp_pack<false>(a.l, C0, C1, pa, true); \
                pv4(a.o, pa, vbo + (unsigned)((j) & 3) * 8192u); } while (0)
#define FOX_TAIL(C0, C1, j) do { FOX_PREFIX(j) bf16x8 pa[4]; \
                exp_pack<false>(a.l, C0, C1, pa, true); \
                pv4(a.o, pa, vbo + (unsigned)((j) & 3) * 8192u); } while (0)
            int j = 0; const int n1 = nact - 2;
#pragma unroll 1
            for (; j + 1 < n1; j += 2) { FOX_FULLZ(sA0, sA1, sB0, sB1, j); FOX_FULLZ(sB0, sB1, sA0, sA1, j + 1); }
            if (j < n1) { FOX_FULLZ(sA0, sA1, sB0, sB1, j); sA0 = sB0; sA1 = sB1; ++j; }
            if (nact >= 2) { FOX_FULLD(sA0, sA1, sB0, sB1, j); ++j; FOX_TAIL(sB0, sB1, j); ++j; }
            else { FOX_TAIL(sA0, sA1, j); ++j; }
#pragma unroll 1
            for (; j < NT; ++j) { FOX_PREFIX(j) }
            if (qb > 0) { FOX_DMA_K(0); FOX_DMA_V(0); FOX_DMA_K(1); FOX_DMA_K(2); FOX_DMA_V(1); }
#undef FOX_FULLZ
#undef FOX_FULLD
#undef FOX_TAIL
#undef FOX_BIAS
#undef FOX_KA
#undef FOX_SCORES_Z
#undef FOX_SCORES_D
#undef FOX_PREFIX
#undef FOX_DMA_K
#undef FOX_DMA_V
            f32x16 res[2];
#pragma unroll
            for (int r = 0; r < 16; ++r) { res[0][r] = 0.f; res[1][r] = 0.f; }
            acc_merge(res, a, 1.0f, wsf, r32, hi);
            store_o_lds(res, O, rowb + q0, h * 64, (LAS unsigned short*)(lds + 110592) + wave * 2048, lane, r32, hi);
        }
    }
}

__device__ __forceinline__ void fox_phase5(LAS unsigned char* lds, const bf16* Q, const bf16* KV, const float* LF, bf16* O) {
    const int tid = threadIdx.x, wave = __builtin_amdgcn_readfirstlane(tid >> 6);
    const unsigned lds0 = (unsigned)(uintptr_t)lds;
    LAS unsigned char* KX = lds + 65536;
    LAS float* nc2 = (LAS float*)(lds + 98304);
    LAS float* wsf = (LAS float*)(lds + 106496) + wave * 64;
    LAS float* wt = (LAS float*)(lds + 108544);
    LAS float* wmx = wt + 16;
    for (int bh = blockIdx.x; bh < NB * NH; bh += gridDim.x) {
        const int b = bh >> 4, h = bh & 15;
        const size_t rowb = (size_t)b * S;
        const bf16* Kg = uni(KV + rowb * FKVW + h * 64); const bf16* Vg = Kg + 1024;
        float kmax;
        {   int tidl = tid; asm volatile("" : "+v"(tidl));
            const int lane = tidl & 63;
            float v[4]; float tot = 0.f, kn = 0.f;
#pragma unroll
            for (int i = 0; i < 4; ++i) { tot += LF[(rowb + 4 * tidl + i) * 16 + h]; v[i] = tot; }
            {
                const u32x4* kr = (const u32x4*)(Kg + (size_t)(tidl >> 3) * FKVW) + (tidl & 7);
#pragma unroll 8
                for (int i = 0; i < 32; ++i) { const u32x4 w = kr[(size_t)i * 64 * (FKVW / 8)];
                    const float a0 = __uint_as_float(w.x << 16), a1 = __uint_as_float(w.x & 0xffff0000u), a2 = __uint_as_float(w.y << 16), a3 = __uint_as_float(w.y & 0xffff0000u);
                    const float a4 = __uint_as_float(w.z << 16), a5 = __uint_as_float(w.z & 0xffff0000u), a6 = __uint_as_float(w.w << 16), a7 = __uint_as_float(w.w & 0xffff0000u);
                    float s = (a0 * a0 + a1 * a1) + (a2 * a2 + a3 * a3) + (a4 * a4 + a5 * a5) + (a6 * a6 + a7 * a7);
                    s = sum8(s);
                    kn = fmaxf(kn, s); } }
            float inc = tot;
#pragma unroll
            for (int o = 1; o < 64; o <<= 1) { const float n = __shfl_up(inc, o), n2 = __shfl_up(kn, o); if (lane >= o) { inc += n; kn = fmaxf(kn, n2); } }
            __syncthreads();
            if (lane == 63) { wt[wave] = inc; wmx[wave] = kn; }
            __syncthreads();
            float base = inc - tot;
            for (int w = 0; w < wave; ++w) base += wt[w];
            kn = wmx[0];
#pragma unroll
            for (int w = 1; w < 8; ++w) kn = fmaxf(kn, wmx[w]);
            kmax = sqrtf(kn);
#pragma unroll
            for (int i = 0; i < 4; ++i) { const float x = -(base + v[i]) * LOG2E; nc2[4 * tidl + i] = x;
                const unsigned hb = f2bf(x); const float r1 = x - __uint_as_float(hb << 16);
                const unsigned lb = f2bf(r1); const float r2 = r1 - __uint_as_float(lb << 16);
                const unsigned llb = f2bf(r2);
                u32x4 e; e.x = hb | (lb << 16); e.y = llb | 0x3f800000u; e.z = 0u; e.w = 0u;
                *(LAS u32x4*)(KX + (size_t)(4 * tidl + i) * 16) = e; }
            __syncthreads();
        }
#pragma unroll 1
        for (int qb = 3; qb >= 0; --qb) {
            int lnu_ = tid & 63; asm volatile("" : "+v"(lnu_));
            const int lane = lnu_, r32 = lnu_ & 31, hi = lnu_ >> 5;
            const int q0 = 512 * qb + 64 * wave, qposA = q0 + r32, qposB = qposA + 32, NT = 8 * qb + 8;
            const int nact = 8 * qb + wave + 1;
            bf16x8 qfA[4], qfB[4];
#pragma unroll
            for (int d0 = 0; d0 < 4; ++d0) { qfA[d0] = *(const bf16x8*)(Q + (rowb + qposA) * D + h * 64 + d0 * 16 + hi * 8); qfB[d0] = *(const bf16x8*)(Q + (rowb + qposB) * D + h * 64 + d0 * 16 + hi * 8); }
            const unsigned mbA = f2bf((qnorm32(qfA) * kmax + nc2[qposA]) * 1.01f + 1.0f), mbB = f2bf((qnorm32(qfB) * kmax + nc2[qposB]) * 1.01f + 1.0f);
            u32x4 qxw; qxw.x = hi ? 0u : 0x3f803f80u; qxw.y = hi ? 0u : (0x00003f80u | ((mbA ^ 0x8000u) << 16)); qxw.z = 0u; qxw.w = 0u;
            const bf16x8 qxA = __builtin_bit_cast(bf16x8, qxw);
            qxw.y = hi ? 0u : (0x00003f80u | ((mbB ^ 0x8000u) << 16));
            const bf16x8 qxB = __builtin_bit_cast(bf16x8, qxw);
            unsigned kofs[4];
#pragma unroll
            for (int d0 = 0; d0 < 4; ++d0) kofs[d0] = lds0 + r32 * 128 + (((2 * d0 + hi) ^ ((r32 >> 1) & 7)) << 4);
            const unsigned vbo = lds0 + 32768 + ((lane >> 4) & 1) * 32 + (lane & 3) * 8 + (4 * hi + ((lane & 15) >> 2)) * 64;
            const unsigned kxo = lds0 + 65536 + r32 * 16;
            const int krow = 8 * wave + (lane >> 3);
            const unsigned kdma = (unsigned)krow * (FKVW * 2) + (((lane & 7) ^ ((krow >> 1) & 7)) << 4);
            const unsigned vdma = (unsigned)(16 * (wave & 3) + (lane >> 2)) * (FKVW * 2) + (wave >> 2) * 64 + (lane & 3) * 16;
            const unsigned kdst = lds0 + wave * 1024, vdst = lds0 + 32768 + wave * 1024;
            Acc aA, aB; acc_init(aA); acc_init(aB);
#define FOX_DMA_K(t) glds16s(kdma, Kg + (size_t)(t) * 64 * FKVW, (unsigned)__builtin_amdgcn_readfirstlane(kdst + ((t) & 3) * 8192))
#define FOX_DMA_V(t) glds16s(vdma, Vg + (size_t)(t) * 64 * FKVW, (unsigned)__builtin_amdgcn_readfirstlane(vdst + ((t) & 3) * 8192))
            asm volatile("s_waitcnt vmcnt(0) lgkmcnt(0)\n\ts_barrier" ::: "memory");
            FOX_DMA_K(0); FOX_DMA_V(0); FOX_DMA_K(1); FOX_DMA_V(1);
#define FOX_PREFIX(t) \
            if ((t) + 1 < NT) asm volatile("s_waitcnt vmcnt(2) lgkmcnt(0)\n\ts_barrier" ::: "memory"); \
            else asm volatile("s_waitcnt vmcnt(0) lgkmcnt(0)\n\ts_barrier" ::: "memory");     \
            if ((t) + 2 < NT) { FOX_DMA_K((t) + 2); FOX_DMA_V((t) + 2); }
#define FOX_STEP(t, DIAG) do { \
            const unsigned so = (unsigned)((t) & 3) * 8192u; \
            const unsigned kxa = kxo + (unsigned)(t) * 1024u; \
            const bf16x8 x0 = *(LAS const bf16x8*)(uintptr_t)kxa, x1 = *(LAS const bf16x8*)(uintptr_t)(kxa + 512); \
            f32x16 a0, a1, b0, b1; \
            if (DIAG) { const int k0_ = 64 * (t); \
                _Pragma("unroll") for (int r = 0; r < 16; ++r) { const int key = k0_ + crow(r, hi); a0[r] = (key > qposA) ? NEG : 0.f; a1[r] = (key + 32 > qposA) ? NEG : 0.f; b0[r] = (key > qposB) ? NEG : 0.f; b1[r] = (key + 32 > qposB) ? NEG : 0.f; } } \
            else { _Pragma("unroll") for (int r = 0; r < 16; ++r) { a0[r] = 0.f; a1[r] = 0.f; b0[r] = 0.f; b1[r] = 0.f; } } \
            _Pragma("unroll") for (int d0 = 0; d0 < 4; ++d0) { \
                const bf16x8 k0f = *(LAS const bf16x8*)(uintptr_t)(kofs[d0] + so), k1f = *(LAS const bf16x8*)(uintptr_t)(kofs[d0] + so + 4096); \
                a0 = __builtin_amdgcn_mfma_f32_32x32x16_bf16(k0f, qfA[d0], a0, 0, 0, 0); a1 = __builtin_amdgcn_mfma_f32_32x32x16_bf16(k1f, qfA[d0], a1, 0, 0, 0); \
                b0 = __builtin_amdgcn_mfma_f32_32x32x16_bf16(k0f, qfB[d0], b0, 0, 0, 0); b1 = __builtin_amdgcn_mfma_f32_32x32x16_bf16(k1f, qfB[d0], b1, 0, 0, 0); } \
            a0 = __builtin_amdgcn_mfma_f32_32x32x16_bf16(x0, qxA, a0, 0, 0, 0); a1 = __builtin_amdgcn_mfma_f32_32x32x16_bf16(x1, qxA, a1, 0, 0, 0); \
            b0 = __builtin_amdgcn_mfma_f32_32x32x16_bf16(x0, qxB, b0, 0, 0, 0); b1 = __builtin_amdgcn_mfma_f32_32x32x16_bf16(x1, qxB, b1, 0, 0, 0); \
            bf16x8 paA[4], paB[4]; \
            exp_pack<false>(aA.l, a0, a1, paA, true); \
            exp_pack<false>(aB.l, b0, b1, paB, true); \
            const unsigned va = vbo + so; \
            _Pragma("unroll") for (int d0 = 0; d0 < 2; ++d0) _Pragma("unroll") for (int ks = 0; ks < 4; ++ks) { \
                const s16x4 lo = vtr((lptr)(uintptr_t)(va + d0 * 4096 + ks * 1024)), hh = vtr((lptr)(uintptr_t)(va + d0 * 4096 + ks * 1024 + 512)); \
                const bf16x8 vf = (bf16x8){lo[0], lo[1], lo[2], lo[3], hh[0], hh[1], hh[2], hh[3]}; \
                aA.o[d0] = __builtin_amdgcn_mfma_f32_32x32x16_bf16(paA[ks], vf, aA.o[d0], 0, 0, 0); \
                aB.o[d0] = __builtin_amdgcn_mfma_f32_32x32x16_bf16(paB[ks], vf, aB.o[d0], 0, 0, 0); } } while (0)
            int t = 0;
#pragma unroll 1
            for (; t + 1 < nact; ++t) { FOX_PREFIX(t) FOX_STEP(t, false); }
            { FOX_PREFIX(t) FOX_STEP(t, true); ++t; }
#pragma unroll 1
            for (; t < NT; ++t) { FOX_PREFIX(t) }
#undef FOX_STEP
#undef FOX_PREFIX
#undef FOX_DMA_K
#undef FOX_DMA_V
            LAS unsigned short* stg = (LAS unsigned short*)(lds + 110592) + wave * 2048;
            f32x16 res[2];
#pragma unroll
            for (int r = 0; r < 16; ++r) { res[0][r] = 0.f; res[1][r] = 0.f; }
            acc_merge(res, aA, 1.0f, wsf, r32, hi);
            store_o_lds(res, O, rowb + q0, h * 64, stg, lane, r32, hi);
#pragma unroll
            for (int r = 0; r < 16; ++r) { res[0][r] = 0.f; res[1][r] = 0.f; }
            acc_merge(res, aB, 1.0f, wsf, r32, hi);
            store_o_lds(res, O, rowb + q0 + 32, h * 64, stg, lane, r32, hi);
        }
    }
}

#define WAIT_BAR() asm volatile("s_waitcnt vmcnt(0) lgkmcnt(0)\n\ts_barrier" ::: "memory")
#define LGKM0() asm volatile("s_waitcnt lgkmcnt(0)" ::: "memory")
__device__ __forceinline__ void nsa_phase4(LAS unsigned char* lds, const bf16* Q, const bf16* KV, const bf16* KC, const bf16* VC, const float* GATE, const float* TBL, bf16* O) {
    const int tid0 = threadIdx.x, wave = __builtin_amdgcn_readfirstlane(tid0 >> 6);
    const int hh = wave >> 1, rhalf = wave & 1;
    const unsigned lds0 = (unsigned)(uintptr_t)lds;
    LAS float* T = (LAS float*)(lds + 65536);
    LAS float* wsf0 = (LAS float*)(lds + 77824) + wave * 64;
    LAS float* score = (LAS float*)(lds + 79872);
    LAS unsigned* maskl = (LAS unsigned*)(lds + 88064);
    LAS unsigned char* park0 = lds + 90112 + wave * 8192;
    LAS float* imph_w = (LAS float*)(lds + 90112 + hh * 8192);
    const int Gd = gridDim.x;
    const bool bal = (Gd == 256);
    const int vc = bal ? ((blockIdx.x & 7) * 32 + (blockIdx.x >> 3)) : (int)blockIdx.x;
    const int nun = bal ? 8 : (2048 - vc + Gd - 1) / Gd;
    int gcur = -1, bgcur = -1;
    float bmaxw = 0.f, kmax_sel = 0.f, kmax_win = 0.f;
    for (int ui = 0; ui < nun; ++ui) {
        int tid = tid0; asm volatile("" : "+v"(tid));
        const int lane = tid & 63, r32 = lane & 31, hi = lane >> 5;
        LAS float* wsf = wsf0; LAS unsigned char* park = park0;
        int bg, qb;
        if (bal) { bg = vc >> 2; const int sub = vc & 3, pr = ui >> 1; qb = 8 * pr + ((ui & 1) ? (7 - sub) : sub); }
        else { const int u = vc + ui * Gd; bg = u >> 5; qb = u & 31; }
        const int b = bg >> 2, g = bg & 3, head = 4 * g + hh;
        const size_t rowb = (size_t)b * S;
        const int q0 = 64 * qb + 32 * rhalf, qpos = q0 + r32;
        const bf16* Ksel = uni(KV + rowb * KVW + 2 * 256 + g * 64); const bf16* Kwin = Ksel + 2 * 256;
        WAIT_BAR();
        if (g != gcur) { for (int i = tid; i < 4 * TLEN; i += 512) T[i] = TBL[g * 4 * TLEN + i]; }
        if (bg != bgcur) {
            float ks = 0.f, kw = 0.f;
            {   const u32x4* k1 = (const u32x4*)(Ksel + (size_t)(tid >> 3) * KVW) + (tid & 7); const u32x4* k2 = (const u32x4*)(Kwin + (size_t)(tid >> 3) * KVW) + (tid & 7);
#pragma unroll 4
                for (int i = 0; i < 32; ++i) { const u32x4 w = k1[(size_t)i * 64 * (KVW / 8)], x = k2[(size_t)i * 64 * (KVW / 8)]; float s1, s2;
                    { const float a0 = __uint_as_float(w.x << 16), a1 = __uint_as_float(w.x & 0xffff0000u), a2 = __uint_as_float(w.y << 16), a3 = __uint_as_float(w.y & 0xffff0000u);
                      const float a4 = __uint_as_float(w.z << 16), a5 = __uint_as_float(w.z & 0xffff0000u), a6 = __uint_as_float(w.w << 16), a7 = __uint_as_float(w.w & 0xffff0000u);
                      s1 = (a0 * a0 + a1 * a1) + (a2 * a2 + a3 * a3) + (a4 * a4 + a5 * a5) + (a6 * a6 + a7 * a7); }
                    { const float a0 = __uint_as_float(x.x << 16), a1 = __uint_as_float(x.x & 0xffff0000u), a2 = __uint_as_float(x.y << 16), a3 = __uint_as_float(x.y & 0xffff0000u);
                      const float a4 = __uint_as_float(x.z << 16), a5 = __uint_as_float(x.z & 0xffff0000u), a6 = __uint_as_float(x.w << 16), a7 = __uint_as_float(x.w & 0xffff0000u);
                      s2 = (a0 * a0 + a1 * a1) + (a2 * a2 + a3 * a3) + (a4 * a4 + a5 * a5) + (a6 * a6 + a7 * a7); }
                    s1 = sum8(s1); s2 = sum8(s2);
                    ks = fmaxf(ks, s1); kw = fmaxf(kw, s2); } }
#pragma unroll
            for (int o = 1; o < 64; o <<= 1) { const float n1 = __shfl_up(ks, o), n2 = __shfl_up(kw, o); if (lane >= o) { ks = fmaxf(ks, n1); kw = fmaxf(kw, n2); } }
            if (lane == 63) { score[wave] = ks; score[8 + wave] = kw; }
            WAIT_BAR();
            ks = score[0]; kw = score[8];
#pragma unroll
            for (int w = 1; w < 8; ++w) { ks = fmaxf(ks, score[w]); kw = fmaxf(kw, score[8 + w]); }
            kmax_sel = sqrtf(ks); kmax_win = sqrtf(kw);
            bgcur = bg;
        }
        const int ncmp = (qb >= 16) ? 2 : 1;
        const bf16* kcg = KC + (size_t)bg * 128 * 64; const bf16* vcg = VC + (size_t)bg * 128 * 64;
        dma_kv(lds + 16384, lds + 32768 + 16384, kcg, vcg, 64, wave, lane);
        if (ncmp == 2) dma_kv(lds + 24576, lds + 32768 + 24576, kcg + 64 * 64, vcg + 64 * 64, 64, wave, lane);
        const int NSEL = qb + 1, jlo = (qb >= 8) ? qb - 8 : 0, NT = NSEL + (qb - jlo + 1);
        const int krow = 8 * wave + (lane >> 3);
        const unsigned kdma = (unsigned)krow * (KVW * 2) + (((lane & 7) ^ ((krow >> 1) & 7)) << 4);
        const unsigned vdma = (unsigned)(16 * (wave & 3) + (lane >> 2)) * (KVW * 2) + (wave >> 2) * 64 + (lane & 3) * 16;
        const unsigned kdst = lds0 + wave * 1024, vdst = lds0 + 32768 + wave * 1024;
#define NSA_KBASE(n) (((n) < NSEL) ? Ksel + (size_t)(n) * 64 * KVW : Kwin + (size_t)(jlo + (n) - NSEL) * 64 * KVW)
#define NSA_DMA_K(n) do { const bf16* kb_ = NSA_KBASE(n); glds16s(kdma, kb_, (unsigned)__builtin_amdgcn_readfirstlane(kdst + ((n) & 3) * 8192)); } while (0)
#define NSA_DMA_V(n) do { const bf16* kb_ = NSA_KBASE(n); glds16s(vdma, kb_ + 256, (unsigned)__builtin_amdgcn_readfirstlane(vdst + ((n) & 3) * 8192)); } while (0)
        NSA_DMA_K(0); NSA_DMA_V(0); NSA_DMA_K(1); NSA_DMA_V(1);
        bf16x8 qf[4];
#pragma unroll
        for (int d0 = 0; d0 < 4; ++d0) qf[d0] = *(const bf16x8*)(Q + (rowb + qpos) * D + head * 64 + d0 * 16 + hi * 8);
        const float* gp = GATE + (rowb + qpos) * 48 + head;
        const float g0 = gp[0], g1 = gp[16], g2 = gp[32];
        f32x16 res[2];
#pragma unroll
        for (int r = 0; r < 16; ++r) { res[0][r] = 0.f; res[1][r] = 0.f; }
        LAS const float* Th = T + hh * TLEN;
        WAIT_BAR();
        if (g != gcur) {
            float bm = fmaxf(fmaxf(Th[63 + lane], Th[127 + lane]), 0.f);
#pragma unroll
            for (int o = 1; o < 64; o <<= 1) { const float n1 = __shfl_up(bm, o); if (lane >= o) bm = fmaxf(bm, n1); }
            bmaxw = __shfl(bm, 63);
            gcur = g;
        }
        {
            f32x16 p0, p1;
#define CMP_SCORES(tile) do { _Pragma("unroll") for (int r = 0; r < 16; ++r) { const int c = crow(r, hi); \
                int da = qpos - 16 * c - 31 - 1024 * (tile), db = da - 512; \
                da = da < -63 ? -63 : (da > 128 ? 128 : da); db = db < -63 ? -63 : (db > 128 ? 128 : db); \
                p0[r] = Th[da + 63]; p1[r] = Th[db + 63]; } \
                qk(p0, p1, lds + 16384 + (tile) * 8192, qf, r32, hi); } while (0)
            float rm = NEG;
            CMP_SCORES(0);
#pragma unroll
            for (int r = 0; r < 16; ++r) rm = fmaxf(rm, fmaxf(p0[r], p1[r]));
            if (ncmp == 2) {
                CMP_SCORES(1);
#pragma unroll
                for (int r = 0; r < 16; ++r) rm = fmaxf(rm, fmaxf(p0[r], p1[r]));
            }
            rm = fmaxf(rm, xhalf(rm));
            const float mm = fmaxf(rm, -1.0e30f);
            float sum = 0.f, tBprev = 0.f;
            float impv[16];
            Acc a; acc_init(a);
            lptr vb = lds + 32768 + 16384 + ((lane >> 4) & 1) * 32 + (lane & 3) * 8 + (4 * hi + ((lane & 15) >> 2)) * 64;
#define IMP_GROUP(P, i, n) do { const float e0 = P[4 * (i)], e1 = P[4 * (i) + 1], e2 = P[4 * (i) + 2], e3 = P[4 * (i) + 3]; \
                const float A = 2.0f * (e0 + e1 + e2) + e3; const float tB = xhalf(e3); \
                impv[n] = A + (hi ? tB : tBprev); tBprev = tB; } while (0)
#define CMP_PASS2(tile) do { \
                bf16x8 vfc[8]; \
                _Pragma("unroll") for (int d0 = 0; d0 < 2; ++d0) _Pragma("unroll") for (int ks = 0; ks < 4; ++ks) { const s16x4 lo = vtr(vb + (tile) * 8192 + d0 * 4096 + ks * 1024), hv = vtr(vb + (tile) * 8192 + d0 * 4096 + ks * 1024 + 512); \
                    vfc[d0 * 4 + ks] = (bf16x8){lo[0], lo[1], lo[2], lo[3], hv[0], hv[1], hv[2], hv[3]}; }     \
                __builtin_amdgcn_sched_barrier(0); \
                _Pragma("unroll") for (int r = 0; r < 16; ++r) { p0[r] = __builtin_amdgcn_exp2f(p0[r] - mm); p1[r] = __builtin_amdgcn_exp2f(p1[r] - mm); sum += p0[r] + p1[r]; } \
                if (qb >= 16) { _Pragma("unroll") for (int i = 0; i < 4; ++i) IMP_GROUP(p0, i, 8 * (tile) + i); \
                _Pragma("unroll") for (int i = 0; i < 4; ++i) IMP_GROUP(p1, i, 8 * (tile) + 4 + i); } \
                bf16x8 pa[4]; \
                _Pragma("unroll") for (int s2 = 0; s2 < 2; ++s2) { u32x4 w0, w1; \
                    w0.x = cvtpk(p0[8 * s2 + 0], p0[8 * s2 + 1]); w0.y = cvtpk(p0[8 * s2 + 2], p0[8 * s2 + 3]); w0.z = cvtpk(p0[8 * s2 + 4], p0[8 * s2 + 5]); w0.w = cvtpk(p0[8 * s2 + 6], p0[8 * s2 + 7]); \
                    w1.x = cvtpk(p1[8 * s2 + 0], p1[8 * s2 + 1]); w1.y = cvtpk(p1[8 * s2 + 2], p1[8 * s2 + 3]); w1.z = cvtpk(p1[8 * s2 + 4], p1[8 * s2 + 5]); w1.w = cvtpk(p1[8 * s2 + 6], p1[8 * s2 + 7]); \
                    pa[s2] = __builtin_bit_cast(bf16x8, w0); pa[2 + s2] = __builtin_bit_cast(bf16x8, w1); } \
                _Pragma("unroll") for (int d0 = 0; d0 < 2; ++d0) \
                _Pragma("unroll") for (int ks = 0; ks < 4; ++ks) a.o[d0] = __builtin_amdgcn_mfma_f32_32x32x16_bf16(pa[ks], vfc[d0 * 4 + ks], a.o[d0], 0, 0, 0); } while (0)
            if (ncmp == 2) { CMP_SCORES(0); }
            CMP_PASS2(0);
            if (ncmp == 2) { CMP_SCORES(1); CMP_PASS2(1); }
            else {
#pragma unroll
                for (int n = 8; n < 16; ++n) impv[n] = 0.f;
            }
#undef CMP_SCORES
#undef IMP_GROUP
#undef CMP_PASS2
            const float lt = sum + xhalf(sum), inv = 1.0f / fmaxf(lt, 1e-30f);
            LAS float* ip = imph_w + (size_t)(rhalf * 32 + r32) * 32 + hi;
            if (qb >= 16) {
#pragma unroll
                for (int n = 0; n < 16; ++n) ip[2 * n] = impv[n] * inv;
            }
            a.l = 0.5f * lt;
            acc_merge(res, a, g0, wsf, r32, hi);
        }
        if (qb >= 16) WAIT_BAR();
        if (qb >= 16) {
            int tk = tid; asm volatile("" : "+v"(tk));
            const int row = tk >> 3, part = tk & 7;
            LAS const float* i0 = (LAS const float*)(lds + 90112) + row * 32, * i1 = (LAS const float*)(lds + 98304) + row * 32, * i2 = (LAS const float*)(lds + 106496) + row * 32, * i3 = (LAS const float*)(lds + 114688) + row * 32;
            u32x4 kc;
#pragma unroll
            for (int e = 0; e < 4; ++e) { const int j = 4 * part + e;
                const float sj = ((i0[j] + i1[j]) + i2[j]) + i3[j];
                const bool visible = j <= qb, forced = (j == 0) || (j == qb) || (j == qb - 1);
                const float scv = visible ? (forced ? 1.0e9f : sj) : -1.0e30f;
                const unsigned ub = __float_as_uint(scv), so = (ub & 0x80000000u) ? ~ub : (ub | 0x80000000u);
                kc[e] = (so & ~31u) | (unsigned)(31 - j); }
            LAS unsigned* skey = (LAS unsigned*)score;
            *(LAS u32x4*)(skey + row * 32 + 4 * part) = kc;
            LGKM0();
            int rk0 = 0, rk1 = 0, rk2 = 0, rk3 = 0;
#pragma unroll
            for (int i4 = 0; i4 < 8; ++i4) { const u32x4 o4 = *(LAS const u32x4*)(skey + row * 32 + 4 * i4);
#pragma unroll
                for (int e = 0; e < 4; ++e) { const unsigned ki = o4[e];
                    rk0 += (ki > kc[0]) ? 1 : 0; rk1 += (ki > kc[1]) ? 1 : 0; rk2 += (ki > kc[2]) ? 1 : 0; rk3 += (ki > kc[3]) ? 1 : 0; } }
            unsigned nib = (rk0 < 16 ? 1u : 0u) | (rk1 < 16 ? 2u : 0u) | (rk2 < 16 ? 4u : 0u) | (rk3 < 16 ? 8u : 0u);
            unsigned mk = nib << (4 * part);
            mk |= __shfl_xor(mk, 1); mk |= __shfl_xor(mk, 2); mk |= __shfl_xor(mk, 4);
            if (part == 0) maskl[row] = mk;
        }
        unsigned mymask = 0xffffffffu;
        if (qb >= 16) { asm volatile("s_waitcnt lgkmcnt(0)\n\ts_barrier" ::: "memory");
            mymask = maskl[rhalf * 32 + r32]; }
        const float qn = qnorm32(qf);
        const unsigned mbs = (f2bf((qn * kmax_sel + bmaxw) * 1.01f + 1.0f) ^ 0x8000u), mbw = (f2bf((qn * kmax_win + bmaxw) * 1.01f + 1.0f) ^ 0x8000u);
        u32x4 kx1w; kx1w.x = 0x00003f80u; kx1w.y = 0u; kx1w.z = 0u; kx1w.w = 0u;
        const bf16x8 kx1 = __builtin_bit_cast(bf16x8, kx1w);
        unsigned kofs[4];
#pragma unroll
        for (int d0 = 0; d0 < 4; ++d0) kofs[d0] = lds0 + r32 * 128 + (((2 * d0 + hi) ^ ((r32 >> 1) & 7)) << 4);
        const unsigned vbo = lds0 + 32768 + ((lane >> 4) & 1) * 32 + (lane & 3) * 8 + (4 * hi + ((lane & 15) >> 2)) * 64;
        LAS const float* Tq = Th + (q0 + r32) - 4 * hi;
#define NSA_QX(n) u32x4 qxw_; { const bool sel_ = (n) < NSEL; const int j_ = sel_ ? (n) : jlo + (n) - NSEL; const bool ok_ = sel_ ? (((mymask >> j_) & 1u) != 0u) : true; \
            qxw_.x = hi ? 0u : (ok_ ? (sel_ ? mbs : mbw) : 0xff00u); qxw_.y = 0u; qxw_.z = 0u; qxw_.w = 0u; } const bf16x8 qx_ = __builtin_bit_cast(bf16x8, qxw_);
#define NSA_KA(n) unsigned ka[4]; { const unsigned so = (unsigned)((n) & 3) * 8192u; ka[0] = kofs[0] + so; ka[1] = kofs[1] + so; ka[2] = kofs[2] + so; ka[3] = kofs[3] + so; }
#define NSA_ISNEAR(n) ((((n) < NSEL) ? 64 * (n) : 64 * (jlo + (n) - NSEL)) + 63 + 128 > q0 || ((n) >= NSEL && jlo + (n) - NSEL == qb - 8))
#define NSA_SCORES_Z(P0, P1, n) do { NSA_QX(n) NSA_KA(n) qk4z(P0, P1, ka, qf); \
            P0 = __builtin_amdgcn_mfma_f32_32x32x16_bf16(kx1, qx_, P0, 0, 0, 0); P1 = __builtin_amdgcn_mfma_f32_32x32x16_bf16(kx1, qx_, P1, 0, 0, 0); } while (0)
#define NSA_SCORES_G(P0, P1, n) do { NSA_QX(n) NSA_KA(n) const int k0_ = ((n) < NSEL) ? 64 * (n) : 64 * (jlo + (n) - NSEL); f32x16 ci0, ci1; gather_c(ci0, ci1, Tq - k0_); \
            qk4c(P0, P1, ci0, ci1, ka, qf); \
            P0 = __builtin_amdgcn_mfma_f32_32x32x16_bf16(kx1, qx_, P0, 0, 0, 0); P1 = __builtin_amdgcn_mfma_f32_32x32x16_bf16(kx1, qx_, P1, 0, 0, 0); } while (0)
        Acc a; acc_init(a);
#define NSA_PREFIX(n) \
        if ((n) + 1 < NT) asm volatile("s_waitcnt vmcnt(2) lgkmcnt(0)\n\ts_barrier" ::: "memory"); \
        else asm volatile("s_waitcnt vmcnt(0) lgkmcnt(0)\n\ts_barrier" ::: "memory");     \
        if ((n) + 2 < NT) { NSA_DMA_K((n) + 2); NSA_DMA_V((n) + 2); } \
        if ((n) == NSEL) { acc_merge(res, a, g1, wsf, r32, hi); acc_init(a); }
#pragma unroll 1
        for (int n = 0; n < NT; ++n) {
            NSA_PREFIX(n)
            f32x16 c0, c1; bf16x8 pa[4];
            bf16x8 vfr[8]; pv4_load(vfr, vbo + (unsigned)(n & 3) * 8192u);
            __builtin_amdgcn_sched_barrier(0);
            if (!NSA_ISNEAR(n)) {
                NSA_SCORES_Z(c0, c1, n);
                exp_pack<false>(a.l, c0, c1, pa, true);
                pv4_mma(a.o, pa, vfr);
            } else {
                NSA_SCORES_G(c0, c1, n);
                exp_pack<false>(a.l, c0, c1, pa, true);
                pv4_mma(a.o, pa, vfr);
            }
        }
#undef NSA_PREFIX
#undef NSA_SCORES_Z
#undef NSA_SCORES_G
#undef NSA_ISNEAR
#undef NSA_KA
#undef NSA_QX
#undef NSA_DMA_K
#undef NSA_DMA_V
#undef NSA_KBASE
        acc_merge(res, a, g2, wsf, r32, hi);
        store_o_lds(res, O, rowb + q0, head * 64, (LAS unsigned short*)park, lane, r32, hi);
    }
}
#undef WAIT_BAR
#undef LGKM0
}

constexpr size_t MiB = 1u << 20;
constexpr size_t WS_SSP = 1 * MiB;
constexpr size_t WS_GATE = 3 * MiB;
constexpr size_t WS_LF = 9 * MiB;
constexpr size_t WS_CUM = 11 * MiB;
constexpr size_t WS_KC = 13 * MiB;
constexpr size_t WS_VC = 14 * MiB;
constexpr size_t WS_MASK = 15 * MiB;
constexpr size_t WS_WIN = 16 * MiB;
constexpr size_t WS_WFOX = 22 * MiB;
constexpr size_t WS_WO0 = 29 * MiB, WS_WO1 = 31 * MiB;
constexpr size_t WS_W1_0 = 33 * MiB, WS_W1_1 = 41 * MiB;
constexpr size_t WS_W2_0 = 49 * MiB, WS_W2_1 = 57 * MiB;
constexpr size_t WS_TBL = 15 * MiB + 512 * 1024;
constexpr size_t WS_WK1 = 65 * MiB;
constexpr size_t WS_XB = 66 * MiB;
constexpr size_t WS_A = 130 * MiB;
constexpr size_t WS_Q = WS_A;
constexpr size_t WS_KV = WS_A + 64 * MiB;
constexpr size_t WS_H = WS_A;
constexpr size_t WS_END = 386 * MiB;

constexpr int NWAVES = 8;
constexpr int LDS_BYTES = 157696;
constexpr int LDS_MISC = 157696 - 64;
constexpr size_t WS_BAR = 0;

#define XB_TMO      128
#define XB_XCNT(j)  (256  + 64 * (j))
#define XB_XSUB(j)  (1280 + 64 * (j))
#define XB_XGEN(j)  (2304 + 64 * (j))
#define XB_TOP      3328
#define XB_TOPGEN   3392
#define XCD_BAR_WORDS 3456
#define XB_SPIN_CAP (1u << 18)

__device__ __forceinline__ unsigned xb_ld(unsigned* p)              { return __hip_atomic_load(p, __ATOMIC_RELAXED, __HIP_MEMORY_SCOPE_AGENT); }
__device__ __forceinline__ unsigned xb_add(unsigned* p, unsigned v) { return __hip_atomic_fetch_add(p, v, __ATOMIC_RELAXED, __HIP_MEMORY_SCOPE_AGENT); }
__device__ __forceinline__ unsigned xb_xcc_id() { return (unsigned)__builtin_amdgcn_s_getreg((3 << 11) | 20) & 0xFu; }
#define XB_SPIN(cond, bar) do { unsigned _sp = 0; while (cond) { __builtin_amdgcn_s_sleep(1); \
    if ((++_sp & 255u) == 0u) { if (xb_ld(&(bar)[XB_TMO])) break; if (_sp > XB_SPIN_CAP) { atomicAdd(&(bar)[XB_TMO], 1u); break; } } } } while (0)

struct XcdBarrier {
    unsigned* bar; unsigned x;
    volatile LAS unsigned* st;
};

__device__ __forceinline__ XcdBarrier xcd_barrier_post(unsigned* bar, volatile LAS unsigned* st) {
    XcdBarrier b; b.bar = bar; b.x = xb_xcc_id(); b.st = st;
    if (threadIdx.x == 0) (void)xb_add(&bar[XB_XCNT(b.x)], 1u);
    return b;
}
__device__ __forceinline__ void xcd_barrier_complete(unsigned* bar, unsigned x, unsigned& nloc, unsigned& nx) {
    const unsigned G = gridDim.x * gridDim.y * gridDim.z;
    unsigned sum, cnt, mine, sp = 0u;
    for (;;) {
        sum = 0u; cnt = 0u; mine = 0u;
#pragma unroll
        for (unsigned j = 0; j < 16; ++j) { const unsigned c = xb_ld(&bar[XB_XCNT(j)]); sum += c; cnt += (c > 0u) ? 1u : 0u; mine = (j == x) ? c : mine; }
        if (sum == G) break;
        __builtin_amdgcn_s_sleep(1);
        if ((++sp & 255u) == 0u) { if (xb_ld(&bar[XB_TMO])) break; if (sp > XB_SPIN_CAP) { atomicAdd(&bar[XB_TMO], 1u); break; } }
    }
    nloc = mine > 0u ? mine : 1u; nx = cnt > 0u ? cnt : 1u;
}

__device__ __forceinline__ void xcd_barrier(const XcdBarrier& b) {
    asm volatile("s_waitcnt vmcnt(0)" ::: "memory");
    __syncthreads();
    if (threadIdx.x == 0) {
        unsigned* bar = b.bar;
        __builtin_amdgcn_s_waitcnt(0);
        unsigned nloc = b.st[0], nx = b.st[1];
        if (nloc == 0u) { xcd_barrier_complete(bar, b.x, nloc, nx); b.st[0] = nloc; b.st[1] = nx; }
        const unsigned old = xb_add(&bar[XB_XSUB(b.x)], 1u);
        const unsigned gen = old / nloc;
        if (old + 1u == (gen + 1u) * nloc) {
            __builtin_amdgcn_fence(__ATOMIC_RELEASE, "agent");
            asm volatile("s_waitcnt vmcnt(0)" ::: "memory");
            const unsigned og = xb_add(&bar[XB_TOP], 1u);
            const unsigned tg = og / nx;
            if (og + 1u == (tg + 1u) * nx) xb_add(&bar[XB_TOPGEN], 1u);
            else XB_SPIN(xb_ld(&bar[XB_TOPGEN]) == tg, bar);
            __builtin_amdgcn_fence(__ATOMIC_ACQUIRE, "agent");
            xb_add(&bar[XB_XGEN(b.x)], 1u);
            asm volatile("s_waitcnt vmcnt(0)" ::: "memory");
        } else {
            XB_SPIN(xb_ld(&bar[XB_XGEN(b.x)]) == gen, bar);
            __builtin_amdgcn_fence(__ATOMIC_ACQUIRE, "agent");
            asm volatile("s_waitcnt vmcnt(0)" ::: "memory");
        }
    }
    __syncthreads();
}

enum Phase { PH_PRO = 0, PH_NSA_IN, PH_CMP, PH_NSA_ATT, PH_NSA_OUT, PH_UP0, PH_DN0, PH_FOX_IN, PH_FOX_ATT, PH_FOX_OUT, PH_UP1, PH_DN1, PH_FINAL, PH_COUNT };
struct Params { const float* in[18]; float* out; unsigned char* ws; int ph_lo, ph_hi; };
enum { I_X = 0, I_RELB, I_NMIX, I_NMLP, I_NSA_WIN, I_PEK, I_WK1, I_WK2, I_PEV, I_WV1, I_WV2, I_NSA_WOUT, I_FOX_WIN, I_FOX_BF, I_FOX_WOUT, I_W1, I_W2, I_FNORM };

__device__ __forceinline__ void phase_prologue(const Params& p, LAS unsigned char* lds, int gw, int NGW, int wave, int lane) {
    LAS float* scr = (LAS float*)(lds + wave * 16384);
    unsigned char* ws = p.ws;
    int base = 0;
#define TMAT(Wp, gainp, K_, N_, NP_, off_) TMATF(false, Wp, gainp, K_, N_, NP_, off_)
#define TMATF(FR_, Wp, gainp, K_, N_, NP_, off_) do { const int nblk = (NP_) / 32, nitems = ((K_) / 64) * nblk; \
        int first = gw - (base % NGW); if (first < 0) first += NGW; \
        for (int it = first; it < nitems; it += NGW) transpose_item<FR_>((Wp), (gainp), (K_), (N_), (bf16*)(ws + (off_)), scr, it, nblk, lane); \
        base += nitems; } while (0)
    TMAT(p.in[I_NSA_WIN], p.in[I_NMIX], D, NSA_IN, NSA_INP, WS_WIN);
    TMAT(p.in[I_NSA_WOUT], (const float*)nullptr, D, D, D, WS_WO0);
    TMATF(true, p.in[I_WK1], (const float*)nullptr, 2048, 64, 64, WS_WK1);
    TMATF(true, p.in[I_WV1], (const float*)nullptr, 2048, 64, 64, WS_WK1 + 64 * 2048 * 2);
#undef TMAT
#undef TMATF
    {
        const float* relb = p.in[I_RELB]; float* TBL = (float*)(ws + WS_TBL);
        for (int i = gw * 64 + lane; i < 16 * 704; i += NGW * 64) { const int h = i / 704, dist = i % 704 - 63; float v;
            if (dist < 0) v = -3.0e38f; else if (dist < 128) v = (relb[rel_bucket(dist) * 16 + h] - relb[31 * 16 + h]) * LOG2E; else if (dist < 512) v = 0.f; else v = -3.0e38f;
            TBL[i] = v; }
    }
    const float* x = p.in[I_X]; bf16* XB = (bf16*)(ws + WS_XB); float* SSP = (float*)(ws + WS_SSP);
    for (int m = 4 * gw; m < M; m += 4 * NGW) xrow4_item(x, XB, SSP, m, lane);
}


__global__ void __launch_bounds__(NWAVES * 64, 2) mega(Params p) {
    extern __shared__ __attribute__((aligned(16))) unsigned char lds_raw[];
    LAS unsigned char* lds = (LAS unsigned char*)lds_raw;
    const int tid = threadIdx.x, lane = tid & 63, wave = __builtin_amdgcn_readfirstlane(tid >> 6);
    const int Gd = gridDim.x, gw = blockIdx.x * NWAVES + wave, NGW = Gd * NWAVES;
    unsigned char* ws = p.ws;
    const int lo = p.ph_lo, hi = p.ph_hi;
    cg::grid_group grid = cg::this_grid();
    volatile LAS unsigned* MISC = (volatile LAS unsigned*)(lds + LDS_MISC);
    if (tid < 16) MISC[tid] = 0u;
    __syncthreads();
    XcdBarrier xbar = xcd_barrier_post((unsigned*)(ws + WS_BAR), MISC);
#define IN(k) (lo <= (k) && (k) < hi)
#define SEAM(k) do { if (IN(k) && IN((k) + 1)) xcd_barrier(xbar); } while (0)
    if (hi < 0) grid.sync();
    bf16* XB = (bf16*)(ws + WS_XB); float* SSP = (float*)(ws + WS_SSP);
    if (IN(PH_PRO)) { phase_prologue(p, lds, gw, NGW, wave, lane); }
    SEAM(PH_PRO);
    if (IN(PH_NSA_IN)) {
        pg8::Gemm g{XB, (const bf16*)(ws + WS_WIN), M, 2560, D}; pg8::StaticOrder So; So.init(M, 2560, Gd, (int)blockIdx.x);
        LAS float* rsl = (LAS float*)(lds + pg8::STAGE_BYTES); auto pre = [&]() { rstd_prepare(rsl, SSP, So); };
        EpiNsaIn E{(bf16*)(ws + WS_Q), (bf16*)(ws + WS_KV), (float*)(ws + WS_GATE), rsl, 0};
        const bool skfirst = (((int)blockIdx.x >> 3) & 1) != 0;
        if (skfirst) { skinny_cols<0>(lds, XB, (const bf16*)(ws + WS_WIN) + (size_t)2560 * D, SSP, nullptr, (float*)(ws + WS_GATE), wave * Gd + (int)blockIdx.x, NGW, lane); __syncthreads(); }
        pg8::gemm_phase<EpiNsaIn, pg8::StaticOrder, true, true, decltype(pre)>(lds, g, So, E, pre);
        if (!skfirst) skinny_cols<0>(lds, XB, (const bf16*)(ws + WS_WIN) + (size_t)2560 * D, SSP, nullptr, (float*)(ws + WS_GATE), wave * Gd + (int)blockIdx.x, NGW, lane);
    }
    SEAM(PH_NSA_IN);
    if (IN(PH_CMP)) { att::compress_phase(lds, (const bf16*)(ws + WS_KV), p.in[I_PEK], p.in[I_PEV], (const bf16*)(ws + WS_WK1), p.in[I_WK2], p.in[I_WV2], (bf16*)(ws + WS_KC), (bf16*)(ws + WS_VC)); }
    SEAM(PH_CMP);
    if (IN(PH_NSA_ATT)) { att::nsa_phase4(lds, (const bf16*)(ws + WS_Q), (const bf16*)(ws + WS_KV), (const bf16*)(ws + WS_KC), (const bf16*)(ws + WS_VC), (const float*)(ws + WS_GATE), (const float*)(ws + WS_TBL), (bf16*)(ws + WS_Q)); }
    SEAM(PH_NSA_ATT);
    const bool sidefirst = (((int)blockIdx.x >> 3) & 1) != 0;
    auto tr_side = [&](const float* W, const float* gain, int K_, int N_, int NP_, size_t off_, bool wavemajor = false) {
        LAS float* scr = (LAS float*)(lds + wave * 16384); const int nblk = NP_ / 32, nitems = (K_ / 64) * nblk;
        for (int it = wavemajor ? wave * Gd + (int)blockIdx.x : gw; it < nitems; it += NGW) transpose_item<false>(W, gain, K_, N_, (bf16*)(ws + off_), scr, it, nblk, lane); };
#define SIDE_BEFORE(stmt) if (sidefirst) { stmt __syncthreads(); }
#define SIDE_AFTER(stmt) if (!sidefirst) { stmt }
    if (IN(PH_NSA_OUT)) {
#define SIDE_W tr_side(p.in[I_W1], p.in[I_NMLP], D, DFF, DFF, WS_W1_0);
        SIDE_BEFORE(SIDE_W)
        pg8::Gemm g{(const bf16*)(ws + WS_Q), (const bf16*)(ws + WS_WO0), M, D, D}; pg8::StaticOrder So; So.init(M, D, Gd, (int)blockIdx.x);
        EpiResid<false> E{nullptr, XB, SSP};
        pg8::gemm_phase<EpiResid<false>, pg8::StaticOrder, true, true>(lds, g, So, E);
        SIDE_AFTER(SIDE_W)
#undef SIDE_W
    }
    SEAM(PH_NSA_OUT);
    if (IN(PH_UP0)) {
#define SIDE_W tr_side(p.in[I_W2], (const float*)nullptr, DFF, D, D, WS_W2_0); tr_side(p.in[I_W1] + (size_t)D * DFF, p.in[I_NMLP] + D, D, DFF, DFF, WS_W1_1);
        SIDE_BEFORE(SIDE_W)
        {   pg8::Gemm g{XB + (size_t)0 * (M / 2) * D, (const bf16*)(ws + WS_W1_0), M / 2, DFF, D}; pg8::StaticOrder So; So.init(M / 2, DFF, Gd, (int)blockIdx.x);
            LAS float* rsl = (LAS float*)(lds + pg8::STAGE_BYTES); auto pre = [&]() { rstd_prepare(rsl, SSP + (size_t)0 * (M / 2) * 16, So); };
            EpiRelu2 E{(bf16*)(ws + WS_H), rsl, 0};
            pg8::gemm_phase<EpiRelu2, pg8::StaticOrder, true, true, decltype(pre)>(lds, g, So, E, pre); }
        SIDE_AFTER(SIDE_W)
#undef SIDE_W
        xcd_barrier(xbar);
        {   pg8::Gemm g{(const bf16*)(ws + WS_H), (const bf16*)(ws + WS_W2_0), M / 2, D, DFF}; pg8::StaticOrder So; So.init(M / 2, D, Gd, (int)blockIdx.x);
            EpiResid<false> E{nullptr, XB + (size_t)0 * (M / 2) * D, SSP + (size_t)0 * (M / 2) * 16};
            pg8::gemm_phase<EpiResid<false>, pg8::StaticOrder, true, true>(lds, g, So, E); }
        xcd_barrier(xbar);
#define SIDE_W tr_side(p.in[I_FOX_WIN], p.in[I_NMIX] + D, D, FOX_IN, FOX_INP, WS_WFOX, true);
        SIDE_BEFORE(SIDE_W)
        {   pg8::Gemm g{XB + (size_t)1 * (M / 2) * D, (const bf16*)(ws + WS_W1_0), M / 2, DFF, D}; pg8::StaticOrder So; So.init(M / 2, DFF, Gd, (int)blockIdx.x);
            LAS float* rsl = (LAS float*)(lds + pg8::STAGE_BYTES); auto pre = [&]() { rstd_prepare(rsl, SSP + (size_t)1 * (M / 2) * 16, So); };
            EpiRelu2 E{(bf16*)(ws + WS_H), rsl, 0};
            pg8::gemm_phase<EpiRelu2, pg8::StaticOrder, true, true, decltype(pre)>(lds, g, So, E, pre); }
        SIDE_AFTER(SIDE_W)
#undef SIDE_W
        xcd_barrier(xbar);
        {   pg8::Gemm g{(const bf16*)(ws + WS_H), (const bf16*)(ws + WS_W2_0), M / 2, D, DFF}; pg8::StaticOrder So; So.init(M / 2, D, Gd, (int)blockIdx.x);
            EpiResid<false> E{nullptr, XB + (size_t)1 * (M / 2) * D, SSP + (size_t)1 * (M / 2) * 16};
            pg8::gemm_phase<EpiResid<false>, pg8::StaticOrder, true, true>(lds, g, So, E); }
    }
    SEAM(PH_DN0);
    if (IN(PH_FOX_IN)) {
        pg8::Gemm g{XB, (const bf16*)(ws + WS_WFOX), M, 3072, D}; pg8::StaticOrder So; So.init(M, 3072, Gd, (int)blockIdx.x);
        LAS float* rsl = (LAS float*)(lds + pg8::STAGE_BYTES); auto pre = [&]() { rstd_prepare(rsl, SSP, So); };
        EpiFoxIn E{(bf16*)(ws + WS_Q), (bf16*)(ws + WS_KV), (float*)(ws + WS_LF), rsl, p.in[I_FOX_BF], 0};
        const bool skfirst = (((int)blockIdx.x >> 3) & 1) != 0;
        if (skfirst) { skinny_cols<1>(lds, XB, (const bf16*)(ws + WS_WFOX) + (size_t)3072 * D, SSP, p.in[I_FOX_BF], (float*)(ws + WS_LF), wave * Gd + (int)blockIdx.x, NGW, lane); __syncthreads(); tr_side(p.in[I_FOX_WOUT], (const float*)nullptr, D, D, D, WS_WO1, true); __syncthreads(); }
        pg8::gemm_phase<EpiFoxIn, pg8::StaticOrder, true, true, decltype(pre)>(lds, g, So, E, pre);
        if (!skfirst) { skinny_cols<1>(lds, XB, (const bf16*)(ws + WS_WFOX) + (size_t)3072 * D, SSP, p.in[I_FOX_BF], (float*)(ws + WS_LF), wave * Gd + (int)blockIdx.x, NGW, lane); __syncthreads(); tr_side(p.in[I_FOX_WOUT], (const float*)nullptr, D, D, D, WS_WO1, true); }
    }
    SEAM(PH_FOX_IN);
    if (IN(PH_FOX_ATT)) { att::fox_phase5(lds, (const bf16*)(ws + WS_Q), (const bf16*)(ws + WS_KV), (const float*)(ws + WS_LF), (bf16*)(ws + WS_Q)); }
    SEAM(PH_FOX_ATT);
    if (IN(PH_FOX_OUT)) {
#define SIDE_W
        SIDE_BEFORE(SIDE_W)
        pg8::Gemm g{(const bf16*)(ws + WS_Q), (const bf16*)(ws + WS_WO1), M, D, D}; pg8::StaticOrder So; So.init(M, D, Gd, (int)blockIdx.x);
        EpiResid<false> E{nullptr, XB, SSP};
        pg8::gemm_phase<EpiResid<false>, pg8::StaticOrder, true, true>(lds, g, So, E);
        SIDE_AFTER(SIDE_W)
#undef SIDE_W
    }
    SEAM(PH_FOX_OUT);
    if (IN(PH_UP1)) {
#define SIDE_W tr_side(p.in[I_W2] + (size_t)DFF * D, (const float*)nullptr, DFF, D, D, WS_W2_1);
        SIDE_BEFORE(SIDE_W)
        {   pg8::Gemm g{XB + (size_t)0 * (M / 2) * D, (const bf16*)(ws + WS_W1_1), M / 2, DFF, D}; pg8::StaticOrder So; So.init(M / 2, DFF, Gd, (int)blockIdx.x);
            LAS float* rsl = (LAS float*)(lds + pg8::STAGE_BYTES); auto pre = [&]() { rstd_prepare(rsl, SSP + (size_t)0 * (M / 2) * 16, So); };
            EpiRelu2 E{(bf16*)(ws + WS_H), rsl, 0};
            pg8::gemm_phase<EpiRelu2, pg8::StaticOrder, true, true, decltype(pre)>(lds, g, So, E, pre); }
        SIDE_AFTER(SIDE_W)
#undef SIDE_W
        xcd_barrier(xbar);
        {   pg8::Gemm g{(const bf16*)(ws + WS_H), (const bf16*)(ws + WS_W2_1), M / 2, D, DFF}; pg8::StaticOrder So; So.init(M / 2, D, Gd, (int)blockIdx.x);
            EpiFinal E{XB + (size_t)0 * (M / 2) * D, p.out + (size_t)0 * (M / 2) * D, p.in[I_FNORM], (unsigned*)(ws + WS_CUM) + (size_t)0 * (M / 2) * 4, (unsigned*)(ws + 16384) + 0 * 64 * 64};
            pg8::gemm_phase<EpiFinal, pg8::StaticOrder, false, true>(lds, g, So, E); }
        xcd_barrier(xbar);
        {   pg8::Gemm g{XB + (size_t)1 * (M / 2) * D, (const bf16*)(ws + WS_W1_1), M / 2, DFF, D}; pg8::StaticOrder So; So.init(M / 2, DFF, Gd, (int)blockIdx.x);
            LAS float* rsl = (LAS float*)(lds + pg8::STAGE_BYTES); auto pre = [&]() { rstd_prepare(rsl, SSP + (size_t)1 * (M / 2) * 16, So); };
            EpiRelu2 E{(bf16*)(ws + WS_H), rsl, 0};
            pg8::gemm_phase<EpiRelu2, pg8::StaticOrder, true, true, decltype(pre)>(lds, g, So, E, pre); }
        xcd_barrier(xbar);
        {   pg8::Gemm g{(const bf16*)(ws + WS_H), (const bf16*)(ws + WS_W2_1), M / 2, D, DFF}; pg8::StaticOrder So; So.init(M / 2, D, Gd, (int)blockIdx.x);
            EpiFinal E{XB + (size_t)1 * (M / 2) * D, p.out + (size_t)1 * (M / 2) * D, p.in[I_FNORM], (unsigned*)(ws + WS_CUM) + (size_t)1 * (M / 2) * 4, (unsigned*)(ws + 16384) + 1 * 64 * 64};
            pg8::gemm_phase<EpiFinal, pg8::StaticOrder, false, true>(lds, g, So, E); }
    }
#undef IN
#undef SEAM
}

extern "C" void kernel_launch(void* const* d_in, const int* in_sizes, int n_in, void* d_out, int out_size, void* d_ws, size_t ws_size, hipStream_t stream) {
    static int grid = 0;
    if (grid == 0) {
        if (n_in != 18 || ws_size < WS_END) { fprintf(stderr, "kernel_launch: unexpected inputs / workspace\n"); grid = -1; return; }
        int dev = 0, cus = 0, per_cu = 0;
        (void)hipGetDevice(&dev); (void)hipDeviceGetAttribute(&cus, hipDeviceAttributeMultiprocessorCount, dev);
        (void)hipFuncSetAttribute((const void*)mega, hipFuncAttributeMaxDynamicSharedMemorySize, LDS_BYTES);
        (void)hipOccupancyMaxActiveBlocksPerMultiprocessor(&per_cu, (const void*)mega, NWAVES * 64, LDS_BYTES);
        if (per_cu < 1) { fprintf(stderr, "kernel_launch: occupancy query reports %d blocks per CU\n", per_cu); grid = -1; return; }
        grid = cus;
    }
    if (grid < 0) return;
    Params p{};
    for (int i = 0; i < 18; ++i) p.in[i] = (const float*)d_in[i];
    p.out = (float*)d_out; p.ws = (unsigned char*)d_ws; p.ph_lo = 0; p.ph_hi = PH_COUNT;
    (void)hipMemsetAsync((char*)d_ws + WS_BAR, 0, 65536, stream);
    void* args[] = {&p};
    hipError_t e = hipLaunchCooperativeKernel((const void*)mega, dim3(grid), dim3(NWAVES * 64), args, LDS_BYTES, stream);
    if (e != hipSuccess) fprintf(stderr, "cooperative launch failed: %s (grid %d)\n", hipGetErrorString(e), grid);
}
```
